# Optimizing an MI355X kernel written in HIP

```python
import jax
import jax.numpy as jnp
from jax import lax
import numpy as np

D_MODEL = 1024
BATCH = 8
SEQ = 4096
DEPTH = 2

CTX_LEN = 256
GRID_W = 64
EPS = 1e-6
N_MOD = 9

GROUP_W = 256
MIX_W = 4 * GROUP_W

FNET_HEADS = 4
FNET_HD = GROUP_W // FNET_HEADS

MLA_HEADS = 4
QK_NOPE = 64
QK_ROPE = 32
AXIS_ROPE = QK_ROPE // 2
V_HD = 64
Q_RANK = 192
KV_RANK = 128
ROPE_BASE = 10000.0
Q_BLOCK = 128

SGU_HEADS = 4
SGU_HD = GROUP_W // SGU_HEADS
SGU_CHUNK = 128

POOL_WINDOWS = (2, 4, 8, 16)
POOL_GROUPS = len(POOL_WINDOWS)
POOL_HD = GROUP_W // POOL_GROUPS

D_FF = 2816

OFF_F = 0
OFF_Q = OFF_F + GROUP_W
OFF_KV = OFF_Q + Q_RANK
OFF_KR = OFF_KV + KV_RANK
OFF_G = OFF_KR + QK_ROPE
OFF_P = OFF_G + 2 * GROUP_W
IN_W = OFF_P + GROUP_W

kernel_name = "hybrid_parallel_group_diffusion_block"


def rms_norm(x, g):
    xf = x.astype(jnp.float32)
    y = xf * lax.rsqrt(jnp.mean(xf * xf, axis=-1, keepdims=True) + EPS)
    return (y * g.astype(jnp.float32)).astype(x.dtype)


def modulate(x, shift, scale):
    return x * (1 + scale) + shift


def swiglu(x, w13, w2):
    a, b = jnp.split(x @ w13, 2, axis=-1)
    return (jax.nn.silu(a) * b) @ w2


def ffn_half_step(h, g, shift, scale, gate, w13, w2):
    return h + 0.5 * gate * swiglu(modulate(rms_norm(h, g), shift, scale), w13, w2)


def axial_rope_tables(n_tokens):
    rows = n_tokens // GRID_W
    row = jnp.repeat(jnp.arange(rows, dtype=jnp.float32), GRID_W)
    col = (jnp.arange(n_tokens) % GRID_W).astype(jnp.float32)
    inv = jnp.power(ROPE_BASE, -jnp.arange(0, AXIS_ROPE, 2, dtype=jnp.float32) / AXIS_ROPE)
    ang = jnp.stack([row[:, None] * inv, col[:, None] * inv], axis=1)
    return jnp.cos(ang), jnp.sin(ang)


def apply_axial_rope(x, cos, sin):
    xs = x.reshape(x.shape[:-1] + (2, 2, AXIS_ROPE // 2)).astype(jnp.float32)
    x1, x2 = xs[..., 0, :], xs[..., 1, :]
    c = cos[None, :, None]
    s = sin[None, :, None]
    out = jnp.stack([x1 * c - x2 * s, x1 * s + x2 * c], axis=-2)
    return out.reshape(x.shape).astype(x.dtype)


def fourier_mixer(z, w_f):
    B, L, _ = z.shape
    zh = z.reshape(B, L, FNET_HEADS, FNET_HD).astype(jnp.float32)
    f = jnp.fft.fft2(zh, axes=(1, 3), norm="ortho").real.astype(z.dtype)
    return jnp.einsum('blhc,hcd->blhd', f, w_f).reshape(B, L, GROUP_W)


def mla_query(cq, g_q, w_uq, rope):
    B, L, _ = cq.shape
    q = (rms_norm(cq, g_q) @ w_uq).reshape(B, L, MLA_HEADS, QK_NOPE + QK_ROPE)
    if rope is not None:
        q = jnp.concatenate([q[..., :QK_NOPE], apply_axial_rope(q[..., QK_NOPE:], *rope)], axis=-1)
    return q


def mla_keys_values(ckv, kr, g_kv, w_ukv, rope):
    B, L, _ = ckv.shape
    kv = (rms_norm(ckv, g_kv) @ w_ukv).reshape(B, L, MLA_HEADS, QK_NOPE + V_HD)
    k_rope = kr[:, :, None, :]
    if rope is not None:
        k_rope = apply_axial_rope(k_rope, *rope)
    k = jnp.concatenate([kv[..., :QK_NOPE], jnp.broadcast_to(k_rope, (B, L, MLA_HEADS, QK_ROPE))], axis=-1)
    return k, kv[..., QK_NOPE:]


def attend(q, k, v):
    s = jnp.einsum('bqhd,bkhd->bhqk', q, k).astype(jnp.float32) * (QK_NOPE + QK_ROPE) ** -0.5
    p = jax.nn.softmax(s, axis=-1).astype(v.dtype)
    return jnp.einsum('bhqk,bkhd->bqhd', p, v)


def blocked_attention(q, k, v):
    B, L, H, dk = q.shape
    qb = q.reshape(B, L // Q_BLOCK, Q_BLOCK, H, dk).transpose(1, 0, 2, 3, 4)
    ob = lax.map(lambda qi: attend(qi, k, v), qb)
    return ob.transpose(1, 0, 2, 3, 4).reshape(B, L, H, v.shape[-1])


def spatial_gating_mixer(z, g_v, w_s, b_s):
    B, L, _ = z.shape
    z = jax.nn.gelu(z)
    u, v = jnp.split(z, 2, axis=-1)
    v = rms_norm(v.reshape(B, L, SGU_HEADS, SGU_HD), g_v)
    v = v.reshape(B, L // SGU_CHUNK, SGU_CHUNK, SGU_HEADS, SGU_HD)
    v = jnp.einsum('hpq,bnqhc->bnphc', w_s, v) + b_s.T[None, None, :, :, None]
    return u * v.reshape(B, L, GROUP_W)


def pooling_mixer(z, w_p, s_p):
    B, L, _ = z.shape
    zf = z.reshape(B, L, POOL_GROUPS, POOL_HD).astype(jnp.float32)
    cs = jnp.concatenate([jnp.zeros((B, 1, POOL_GROUPS, POOL_HD), jnp.float32), jnp.cumsum(zf, axis=1)], axis=1)
    t = jnp.arange(L)[:, None]
    w = jnp.array(POOL_WINDOWS, dtype=jnp.int32)[None, :]
    lo = jnp.clip(t - w // 2, 0, L)
    hi = jnp.clip(t - w // 2 + w, 0, L)
    gi = jnp.arange(POOL_GROUPS)[None, :]
    win_sum = cs[:, hi, gi] - cs[:, lo, gi]
    pooled = win_sum / (hi - lo).astype(jnp.float32)[None, :, :, None] - zf
    y = jnp.einsum('blgc,gcd->blgd', pooled.astype(z.dtype), w_p).reshape(B, L, GROUP_W)
    return y * s_p


def mix_heads(z, k, v, rope, w_fnet, g_q, w_uq, g_sgu, w_sgu, b_sgu, w_pool, s_pool):
    B, L, _ = z.shape
    q = mla_query(z[..., OFF_Q:OFF_KV], g_q, w_uq, rope)
    att = blocked_attention(q, k, v).reshape(B, L, GROUP_W)
    return jnp.concatenate([
        fourier_mixer(z[..., OFF_F:OFF_Q], w_fnet),
        att,
        spatial_gating_mixer(z[..., OFF_G:OFF_P], g_sgu, w_sgu, b_sgu),
        pooling_mixer(z[..., OFF_P:], w_pool, s_pool),
    ], axis=-1)


def setup_inputs(seed: int = 0) -> dict:
    key = jax.random.key(seed)
    ks = iter(jax.random.split(key, 32))
    f32 = jnp.float32

    def nrm(shape, scale):
        return jax.random.normal(next(ks), shape, f32) * scale

    def gain(shape):
        return 1.0 + 0.1 * jax.random.normal(next(ks), shape, f32)

    n = DEPTH
    return {
        "x": nrm((BATCH, SEQ, D_MODEL), 1.0),
        "c": nrm((BATCH, D_MODEL), 1.0),
        "ctx": nrm((BATCH, CTX_LEN, D_MODEL), 1.0),
        "c_ctx": nrm((D_MODEL,), 1.0),
        "w_ada": nrm((n, D_MODEL, N_MOD * D_MODEL), 0.5 * D_MODEL ** -0.5),
        "b_ada": nrm((n, N_MOD * D_MODEL), 0.02),
        "g_ffn1": gain((n, D_MODEL)),
        "w13_ffn1": nrm((n, D_MODEL, 2 * D_FF), D_MODEL ** -0.5),
        "w2_ffn1": nrm((n, D_FF, D_MODEL), D_FF ** -0.5),
        "g_mix": gain((n, D_MODEL)),
        "w_in": nrm((n, D_MODEL, IN_W), D_MODEL ** -0.5),
        "w_fnet": nrm((n, FNET_HEADS, FNET_HD, FNET_HD), FNET_HD ** -0.5),
        "g_q": gain((n, Q_RANK)),
        "w_uq": nrm((n, Q_RANK, MLA_HEADS * (QK_NOPE + QK_ROPE)), Q_RANK ** -0.5),
        "g_kv": gain((n, KV_RANK)),
        "w_ukv": nrm((n, KV_RANK, MLA_HEADS * (QK_NOPE + V_HD)), KV_RANK ** -0.5),
        "g_sgu": gain((n, SGU_HEADS, SGU_HD)),
        "w_sgu": nrm((n, SGU_HEADS, SGU_CHUNK, SGU_CHUNK), SGU_CHUNK ** -0.5),
        "b_sgu": gain((n, SGU_HEADS, SGU_CHUNK)),
        "w_pool": nrm((n, POOL_GROUPS, POOL_HD, POOL_HD), POOL_HD ** -0.5),
        "s_pool": gain((n, GROUP_W)),
        "w_out": nrm((n, MIX_W, D_MODEL), MIX_W ** -0.5),
        "g_ffn2": gain((n, D_MODEL)),
        "w13_ffn2": nrm((n, D_MODEL, 2 * D_FF), D_MODEL ** -0.5),
        "w2_ffn2": nrm((n, D_FF, D_MODEL), D_FF ** -0.5),
        "g_final": gain((D_MODEL,)),
    }


def reference(x, c, ctx, c_ctx, w_ada, b_ada, g_ffn1, w13_ffn1, w2_ffn1, g_mix, w_in, w_fnet,
              g_q, w_uq, g_kv, w_ukv, g_sgu, w_sgu, b_sgu, w_pool, s_pool, w_out,
              g_ffn2, w13_ffn2, w2_ffn2, g_final):
    B, L, _ = x.shape
    rope = axial_rope_tables(L)
    silu_c = jax.nn.silu(c)
    silu_cc = jax.nn.silu(c_ctx)[None]
    h, hc = x, ctx
    for i in range(DEPTH):
        last = i == DEPTH - 1
        m = jnp.split((silu_c @ w_ada[i] + b_ada[i])[:, None, :], N_MOD, axis=-1)
        mc = jnp.split((silu_cc @ w_ada[i] + b_ada[i])[:, None, :], N_MOD, axis=-1)

        h = ffn_half_step(h, g_ffn1[i], m[0], m[1], m[2], w13_ffn1[i], w2_ffn1[i])
        hc = ffn_half_step(hc, g_ffn1[i], mc[0], mc[1], mc[2], w13_ffn1[i], w2_ffn1[i])

        n_lat = modulate(rms_norm(h, g_mix[i]), m[3], m[4])
        n_ctx = modulate(rms_norm(hc, g_mix[i]), mc[3], mc[4])
        z = n_lat @ w_in[i]
        zc = n_ctx @ (w_in[i][:, OFF_KV:OFF_G] if last else w_in[i])
        zc_kv = zc if last else zc[..., OFF_KV:OFF_G]
        kc, vc = mla_keys_values(zc_kv[..., :KV_RANK], zc_kv[..., KV_RANK:], g_kv[i], w_ukv[i], None)
        k, v = mla_keys_values(z[..., OFF_KV:OFF_KR], z[..., OFF_KR:OFF_G], g_kv[i], w_ukv[i], rope)
        mix_p = (w_fnet[i], g_q[i], w_uq[i], g_sgu[i], w_sgu[i], b_sgu[i], w_pool[i], s_pool[i])
        y = mix_heads(z, jnp.concatenate([k, kc], axis=1), jnp.concatenate([v, vc], axis=1), rope, *mix_p) @ w_out[i]
        h = h + m[5] * y

        h = ffn_half_step(h, g_ffn2[i], m[6], m[7], m[8], w13_ffn2[i], w2_ffn2[i])

        if not last:
            yc = mix_heads(zc, kc, vc, None, *mix_p) @ w_out[i]
            hc = hc + mc[5] * yc
            hc = ffn_half_step(hc, g_ffn2[i], mc[6], mc[7], mc[8], w13_ffn2[i], w2_ffn2[i])
    return rms_norm(h, g_final)
```

```cpp
#include <hip/hip_runtime.h>
#include <hip/hip_cooperative_groups.h>
#include <cstdio>
namespace cg = cooperative_groups;

#ifndef REPMASK
#define REPMASK 0
#endif
#ifndef REPN
#define REPN 1
#endif
#ifndef ONE_LAUNCH
#define ONE_LAUNCH 1
#endif

#define LAS __attribute__((address_space(3)))
typedef unsigned short bf16_t;
typedef short bf16x8 __attribute__((ext_vector_type(8)));
typedef float f32x4 __attribute__((ext_vector_type(4)));
typedef float f32x2 __attribute__((ext_vector_type(2)));
typedef unsigned u32x2 __attribute__((ext_vector_type(2)));
typedef unsigned u32x4 __attribute__((ext_vector_type(4)));

constexpr int D = 1024, NB = 8, SEQ = 4096, CTX = 256, ML = NB * SEQ, MC = NB * CTX, MT = ML + MC, DFF = 2816;
constexpr int ZW = 1120;
constexpr int NIN = 1792;
constexpr int KQ = 384;
constexpr int NKEY = SEQ + CTX;
constexpr int NMOD = 9 * D;
constexpr int LDS_BYTES = 147456;
constexpr int NPH = 26;

constexpr size_t O_HC = 0;
constexpr size_t O_A1 = O_HC + (size_t)MC * D * 4;
constexpr size_t O_U = O_A1 + (size_t)MT * D * 2;
constexpr size_t O_Z = O_U;
constexpr size_t O_ZT = O_Z + (size_t)MT * ZW * 2;
constexpr size_t O_ZTC = O_ZT + (size_t)NB * 256 * 8192 * 2;
constexpr size_t O_AQ = O_ZTC + (size_t)NB * 256 * 512 * 2;
constexpr size_t O_Q = O_AQ + (size_t)MT * KQ * 2;
constexpr size_t O_K = O_Q + (size_t)NB * 4 * NKEY * 96 * 2;
constexpr size_t O_VT = O_K + (size_t)NB * 4 * NKEY * 96 * 2;
constexpr size_t O_FE = O_VT + (size_t)NB * 4 * 64 * NKEY * 2;
constexpr size_t O_FO = O_FE + (size_t)NB * 256 * 2048 * 2;
constexpr size_t O_CE = O_FO + (size_t)NB * 256 * 2048 * 2;
constexpr size_t O_SO = O_CE + (size_t)NB * 2048 * 256 * 4;
constexpr size_t O_FX = O_SO + (size_t)NB * 2048 * 256 * 4;
constexpr size_t O_UEND = O_FX + (size_t)NB * 256 * 2 * 4;
constexpr size_t SZ_HID = (size_t)MT * DFF * 2;
constexpr size_t O_W = O_U + (O_UEND - O_U > SZ_HID ? O_UEND - O_U : SZ_HID);
constexpr size_t W_13A = 0;
constexpr size_t W_2A = W_13A + (size_t)2 * DFF * D * 2;
constexpr size_t W_IN = W_2A + (size_t)D * DFF * 2;
constexpr size_t W_QKV = W_IN + (size_t)NIN * D * 2;
constexpr size_t W_OUT = W_QKV + (size_t)1024 * KQ * 2;
constexpr size_t W_13B = W_OUT + (size_t)D * D * 2;
constexpr size_t W_2B = W_13B + (size_t)2 * DFF * D * 2;
constexpr size_t W_S = W_2B + (size_t)D * DFF * 2;
constexpr size_t W_LAYER = W_S + (size_t)4 * 128 * 128 * 2;
constexpr size_t O_DFT = O_W + 2 * W_LAYER;
constexpr size_t O_DFTC = O_DFT + (size_t)2 * 2048 * 2048 * 2;
constexpr size_t O_MOD = O_DFTC + (size_t)256 * 512 * 2;
constexpr size_t O_BAR = O_MOD + (size_t)2 * 9 * NMOD * 4;
constexpr size_t O_PART = O_BAR + 16384;
constexpr size_t WS_END = O_PART + (size_t)4 * MC * D * 4;

struct P { const float* in[26]; float* out; unsigned char* ws; };
typedef const P __attribute__((address_space(4))) CP;
enum { I_X = 0, I_C, I_CTX, I_CCTX, I_WADA, I_BADA, I_GF1, I_W13A, I_W2A, I_GMIX, I_WIN, I_WF, I_GQ, I_WUQ, I_GKV, I_WUKV, I_GSGU, I_WSGU, I_BSGU, I_WP, I_SP, I_WOUT, I_GF2, I_W13B, I_W2B, I_GFIN };

__device__ __forceinline__ unsigned pk2(float lo, float hi) { unsigned r; asm volatile("v_cvt_pk_bf16_f32 %0, %1, %2" : "=v"(r) : "v"(lo), "v"(hi)); return r; }
__device__ __forceinline__ bf16_t f2bf(float f) { return (bf16_t)(pk2(f, 0.f) & 0xffffu); }
__device__ __forceinline__ float bf2f(unsigned b) { return __uint_as_float(b << 16); }
__device__ __forceinline__ float wave_sum(float v) {
#pragma unroll
    for (int o = 1; o < 64; o <<= 1) v += __shfl_xor(v, o);
    return v;
}
__device__ __forceinline__ float silu_f(float a) { return a * __builtin_amdgcn_rcpf(1.f + __expf(-a)); }
__device__ __forceinline__ float gelu_f(float x) { const float y = 0.7978845608028654f * (x + 0.044715f * x * x * x); return x * __builtin_amdgcn_rcpf(1.f + __expf(-2.f * y)); }
#define LDS_WAIT() asm volatile("s_waitcnt lgkmcnt(0)" ::: "memory")


#define XB_TMO      128
#define XB_XCNT(j)  (256  + 64 * (j))
#define XB_XSUB(j)  (1280 + 64 * (j))
#define XB_XGEN(j)  (2304 + 64 * (j))
#define XB_TOP      3328
#define XB_TOPGEN   3392
#define XCD_BAR_WORDS 3456
#define XB_SPIN_CAP (1u << 18)
__device__ __forceinline__ unsigned xb_ld(unsigned* p)              { return __hip_atomic_load(p, __ATOMIC_RELAXED, __HIP_MEMORY_SCOPE_AGENT); }
__device__ __forceinline__ unsigned xb_add(unsigned* p, unsigned v) { return __hip_atomic_fetch_add(p, v, __ATOMIC_RELAXED, __HIP_MEMORY_SCOPE_AGENT); }
__device__ __forceinline__ unsigned xb_xcc_id() { return (unsigned)__builtin_amdgcn_s_getreg((3 << 11) | 20) & 0xFu; }
#define XB_SPIN(cond, bar) do { unsigned _sp = 0; while (cond) { __builtin_amdgcn_s_sleep(1); \
    if ((++_sp & 255u) == 0u) { if (xb_ld(&(bar)[XB_TMO])) break; if (_sp > XB_SPIN_CAP) { atomicAdd(&(bar)[XB_TMO], 1u); break; } } } } while (0)
__device__ __forceinline__ void xcd_barrier_complete(unsigned* bar, unsigned x, unsigned G, unsigned& nloc, unsigned& nx) {
    unsigned sum, cnt, mine, sp = 0u;
    for (;;) {
        sum = 0u; cnt = 0u; mine = 0u;
#pragma unroll
        for (unsigned j = 0; j < 16; ++j) { const unsigned c = xb_ld(&bar[XB_XCNT(j)]); sum += c; cnt += (c > 0u) ? 1u : 0u; mine = (j == x) ? c : mine; }
        if (sum == G) break;
        __builtin_amdgcn_s_sleep(1);
        if ((++sp & 255u) == 0u) { if (xb_ld(&bar[XB_TMO])) break; if (sp > XB_SPIN_CAP) { atomicAdd(&bar[XB_TMO], 1u); break; } }
    }
    nloc = mine > 0u ? mine : 1u; nx = cnt > 0u ? cnt : 1u;
}
__device__ __forceinline__ void xcd_barrier(unsigned* bar, const unsigned x, volatile LAS unsigned* st, const int tid, const unsigned G) {
    asm volatile("s_waitcnt vmcnt(0)" ::: "memory");
    __syncthreads();
    if (tid == 0) {
        __builtin_amdgcn_s_waitcnt(0);
        unsigned nloc = st[0], nx = st[1];
        if (nloc == 0u) { xcd_barrier_complete(bar, x, G, nloc, nx); st[0] = nloc; st[1] = nx; }
        const unsigned old = xb_add(&bar[XB_XSUB(x)], 1u);
        const unsigned gen = old / nloc;
        if (old + 1u == (gen + 1u) * nloc) {
            __builtin_amdgcn_fence(__ATOMIC_RELEASE, "agent");
            asm volatile("s_waitcnt vmcnt(0)" ::: "memory");
            const unsigned og = xb_add(&bar[XB_TOP], 1u);
            const unsigned tg = og / nx;
            if (og + 1u == (tg + 1u) * nx) xb_add(&bar[XB_TOPGEN], 1u);
            else XB_SPIN(xb_ld(&bar[XB_TOPGEN]) == tg, bar);
            __builtin_amdgcn_fence(__ATOMIC_ACQUIRE, "agent");
            xb_add(&bar[XB_XGEN(x)], 1u);
            asm volatile("s_waitcnt vmcnt(0)" ::: "memory");
        } else {
            XB_SPIN(xb_ld(&bar[XB_XGEN(x)]) == gen, bar);
            __builtin_amdgcn_fence(__ATOMIC_ACQUIRE, "agent");
            asm volatile("s_waitcnt vmcnt(0)" ::: "memory");
        }
    }
    __syncthreads();
}

constexpr int BM = 256, BK = 64, HALF = 128, HTB = HALF * BK * 2, NXCD = 8, WGM = 4;
__device__ __forceinline__ int lds_byte(int r, int c) { const int st = (r >> 4) * 2 + (c >> 5), rr = r & 15, cc = c & 31, ob = rr * 64 + cc * 2; return st * 1024 + (ob ^ (((ob >> 9) & 1) << 5)); }
__device__ __forceinline__ void stage_rc(int b, int& R, int& C) { const int st = b / 1024, sb = b % 1024, swz = sb ^ (((sb >> 9) & 1) << 5); R = (st >> 1) * 16 + swz / 64; C = (st & 1) * 32 + (swz % 64) / 2; }
struct Unit { int pm, pn, koff, nt, ks; };
struct Gemm { const bf16_t* A; const bf16_t* Bt; int M, N, K; };
struct Sched {
    int nM, nN, nwg, G, c, ntf;
    __device__ __forceinline__ void init(int M, int N, int G_, int c_) { nM = M / BM; nN = N / BM; nwg = nM * nN; G = G_; c = c_; ntf = 0; }
    __device__ __forceinline__ bool next(int i, Unit& u) const {
        const int L = i * G + c; const bool ok = (c >= 0) && (L < nwg);
        int wgid = ok ? L : 0; { const int q = nwg / NXCD, r = nwg % NXCD, xcd = wgid % NXCD, off = wgid / NXCD; wgid = (xcd < r ? xcd * (q + 1) : r * (q + 1) + (xcd - r) * q) + off; }
        const int nig = WGM * nN, gid = wgid / nig, fm = gid * WGM, gsz = (nM - fm) < WGM ? (nM - fm) : WGM;
        u.pm = fm + ((wgid % nig) % gsz); u.pn = (wgid % nig) / gsz; u.koff = 0; u.nt = ntf; u.ks = -1; return ok;
    }
};
struct Sched2 {
    int nM, nN, nwg, G, c, ntf, nCu, K;
    __device__ __forceinline__ void init(int N, int K_, int G_, int c_, bool with_ctx) { nM = ML / BM; nN = N / BM; nwg = nM * nN; G = G_; c = c_; ntf = K_ / BK; nCu = with_ctx ? (MC / BM) * nN * 4 : 0; K = K_; }
    __device__ __forceinline__ bool next(int i, Unit& u) const {
        const int L = i * G + c; const bool lat = L < nwg; const bool ok = (c >= 0) && (L < nwg + nCu);
        int wgid = lat ? L : 0; { const int q = nwg / NXCD, r = nwg % NXCD, xcd = wgid % NXCD, off = wgid / NXCD; wgid = (xcd < r ? xcd * (q + 1) : r * (q + 1) + (xcd - r) * q) + off; }
        const int nig = WGM * nN, gid = wgid / nig, fm = gid * WGM, gsz = (nM - fm) < WGM ? (nM - fm) : WGM;
        const int lpm = fm + ((wgid % nig) % gsz), lpn = (wgid % nig) / gsz;
        const int s = ok && !lat ? L - nwg : 0, t = s >> 2, ks = s & 3, base = (ntf >> 3) * 2, rem = (ntf - 4 * base) >> 1;
        u.pm = lat ? lpm : nM + t / nN; u.pn = lat ? lpn : t % nN; u.koff = lat ? 0 : BK * (ks * base + 2 * (ks < rem ? ks : rem)); u.nt = lat ? ntf : base + (ks < rem ? 2 : 0); u.ks = lat ? -1 : ks; return ok;
    }
};
template <class Epi, class SchedT>
__device__ __forceinline__ void gemm_phase(const int tid, LAS unsigned char* lds, const Gemm g, const SchedT& S, const Epi& E) {
    const int wid = __builtin_amdgcn_readfirstlane(tid >> 6), lane = tid & 63, wr = wid >> 2, wc = wid & 3, fr = lane & 15, fq = lane >> 4;
    const int K = g.K;
    unsigned voffA[2];
#pragma unroll
    for (int i = 0; i < 2; ++i) { int R, C; stage_rc(tid * 16 + i * 8192, R, C); voffA[i] = (unsigned)(R * K + C) * 2u; }
    const size_t kstep = (size_t)(BK * 2);
    const size_t hstep = (size_t)HALF * K * 2;
    const size_t tstep = 2 * hstep;
    const unsigned ldsw = (unsigned)wid * 1024u;
    const int aoff = lds_byte(wr * 64 + fr, fq * 8), boff = lds_byte(wc * 32 + fr, fq * 8);
#define PG8_SA(b, h) (((b) * 2 + (h)) * HTB)
#define PG8_SB(b, h) ((4 + (b) * 2 + (h)) * HTB)
#define PG8_STAGE(bufoff, gbase) do { _Pragma("unroll") for (int _i = 0; _i < 2; ++_i) \
        __builtin_amdgcn_global_load_lds((const unsigned*)((const char*)(gbase) + voffA[_i]), (LAS unsigned*)(lds + (bufoff) + ldsw + _i * 8192), 16, 0, 0); } while (0)
#define PG8_LDA(dst, b, h) do { _Pragma("unroll") for (int m = 0; m < 4; ++m) _Pragma("unroll") for (int k = 0; k < 2; ++k) dst[m][k] = *(const LAS bf16x8*)(lds + PG8_SA(b, h) + aoff + m * 2048 + k * 1024); } while (0)
#define PG8_LDB(dst, b, h) do { _Pragma("unroll") for (int n = 0; n < 2; ++n) _Pragma("unroll") for (int k = 0; k < 2; ++k) dst[n][k] = *(const LAS bf16x8*)(lds + PG8_SB(b, h) + boff + n * 2048 + k * 1024); } while (0)
#define PG8_MMA(ai, bj, At, Bt) do { __builtin_amdgcn_s_setprio(1); _Pragma("unroll") for (int m = 0; m < 4; ++m) _Pragma("unroll") for (int n = 0; n < 2; ++n) _Pragma("unroll") for (int k = 0; k < 2; ++k) \
        acc[ai][bj][m][n] = __builtin_amdgcn_mfma_f32_16x16x32_bf16(Bt[n][k], At[m][k], acc[ai][bj][m][n], 0, 0, 0); __builtin_amdgcn_s_setprio(0); } while (0)
#define PG8_WAIT_V(n) asm volatile("s_waitcnt vmcnt(" #n ")" ::: "memory")
#define PG8_WAIT_L(n) asm volatile("s_waitcnt lgkmcnt(" #n ")" ::: "memory")
#define PG8_BAR __builtin_amdgcn_s_barrier()
#define PG8_SCHED __builtin_amdgcn_sched_barrier(0)
    Unit cur, nxt; int ui = 0;
    if (!S.next(0, cur)) return;
    f32x4 acc[2][2][4][2];
#pragma unroll
    for (int a = 0; a < 2; ++a)
#pragma unroll
        for (int b = 0; b < 2; ++b)
#pragma unroll
            for (int m = 0; m < 4; ++m)
#pragma unroll
                for (int n = 0; n < 2; ++n) acc[a][b][m][n] = (f32x4){0.f, 0.f, 0.f, 0.f};
    bf16x8 At[4][2], B0[2][2], B1[2][2];
    const char* cA = (const char*)g.A + (size_t)cur.pm * tstep + (size_t)cur.koff * 2; const char* cB = (const char*)g.Bt + (size_t)cur.pn * tstep + (size_t)cur.koff * 2;
    int nt = cur.nt;
    PG8_STAGE(PG8_SB(0, 0), cB); PG8_STAGE(PG8_SA(0, 0), cA); PG8_STAGE(PG8_SB(0, 1), cB + hstep); PG8_STAGE(PG8_SA(0, 1), cA + hstep);
    if (wr == 1) PG8_BAR;
    PG8_WAIT_V(4); PG8_BAR;
    PG8_STAGE(PG8_SB(1, 0), cB + kstep); PG8_STAGE(PG8_SA(1, 0), cA + kstep); PG8_STAGE(PG8_SB(1, 1), cB + hstep + kstep);
    PG8_WAIT_V(6); PG8_BAR;
    for (;;) {
        const bool has_next = S.next(ui + 1, nxt);
        const char* nA = has_next ? (const char*)g.A + (size_t)nxt.pm * tstep + (size_t)nxt.koff * 2 : cA; const char* nB = has_next ? (const char*)g.Bt + (size_t)nxt.pn * tstep + (size_t)nxt.koff * 2 : cB;
        for (int t = 0; t < nt; t += 2) {
            const bool last = (t == nt - 2);
            const char* a1 = cA + (size_t)(t + 1) * kstep;
            const char* a2 = last ? nA : cA + (size_t)(t + 2) * kstep; const char* b2 = last ? nB : cB + (size_t)(t + 2) * kstep;
            const char* a3 = a2 + kstep; const char* b3 = b2 + kstep;
            PG8_LDB(B0, 0, 0); PG8_SCHED; PG8_LDA(At, 0, 0); PG8_STAGE(PG8_SA(1, 1), a1 + hstep);
            PG8_WAIT_L(8); PG8_BAR; PG8_WAIT_L(0); PG8_MMA(0, 0, At, B0); PG8_BAR; PG8_SCHED;
            PG8_LDB(B1, 0, 1); PG8_STAGE(PG8_SB(0, 0), b2);
            PG8_BAR; PG8_WAIT_L(0); PG8_MMA(0, 1, At, B1); PG8_BAR;
            PG8_LDA(At, 0, 1); PG8_STAGE(PG8_SA(0, 0), a2);
            PG8_BAR; PG8_WAIT_L(0); PG8_MMA(1, 0, At, B0); PG8_BAR; PG8_SCHED;
            PG8_STAGE(PG8_SB(0, 1), b2 + hstep);
            PG8_WAIT_V(6); PG8_BAR; PG8_MMA(1, 1, At, B1); PG8_BAR;
            PG8_LDB(B0, 1, 0); PG8_SCHED; PG8_LDA(At, 1, 0); PG8_STAGE(PG8_SA(0, 1), a2 + hstep);
            PG8_WAIT_L(8); PG8_BAR; PG8_WAIT_L(0); PG8_MMA(0, 0, At, B0); PG8_BAR; PG8_SCHED;
            PG8_LDB(B1, 1, 1); PG8_STAGE(PG8_SB(1, 0), b3);
            PG8_BAR; PG8_WAIT_L(0); PG8_MMA(0, 1, At, B1); PG8_BAR;
            PG8_LDA(At, 1, 1); PG8_STAGE(PG8_SA(1, 0), a3);
            PG8_BAR; PG8_WAIT_L(0); PG8_MMA(1, 0, At, B0); PG8_BAR; PG8_SCHED;
            PG8_STAGE(PG8_SB(1, 1), b3 + hstep);
            PG8_WAIT_V(6); PG8_BAR; PG8_MMA(1, 1, At, B1); PG8_BAR;
        }
        E(acc, cur, wr, wc, fr, fq);
        if (!has_next) break;
#pragma unroll
        for (int a = 0; a < 2; ++a)
#pragma unroll
            for (int b = 0; b < 2; ++b)
#pragma unroll
                for (int m = 0; m < 4; ++m)
#pragma unroll
                    for (int n = 0; n < 2; ++n) acc[a][b][m][n] = (f32x4){0.f, 0.f, 0.f, 0.f};
        cur = nxt; cA = nA; cB = nB; nt = cur.nt; ++ui;
    }
    PG8_WAIT_V(0);
    if (wr == 0) PG8_BAR;
    PG8_BAR;
}

struct EpiSwiglu {
    bf16_t* hid;
    __device__ __forceinline__ void operator()(const f32x4 (&acc)[2][2][4][2], const Unit& u, int wr, int wc, int fr, int fq) const {
        const int row0 = u.pm * BM + wr * 64 + fr, col0 = u.pn * 128 + wc * 32 + 8 * fq;
#pragma unroll
        for (int ai = 0; ai < 2; ++ai)
#pragma unroll
            for (int m = 0; m < 4; ++m) { bf16_t* rowp = hid + (size_t)(row0 + ai * HALF + m * 16) * DFF + col0;
                const f32x4 a0 = acc[ai][0][m][0], b0 = acc[ai][1][m][0], a1 = acc[ai][0][m][1], b1 = acc[ai][1][m][1];
                u32x4 o; o.x = pk2(silu_f(a0[0]) * b0[0], silu_f(a0[1]) * b0[1]); o.y = pk2(silu_f(a0[2]) * b0[2], silu_f(a0[3]) * b0[3]);
                o.z = pk2(silu_f(a1[0]) * b1[0], silu_f(a1[1]) * b1[1]); o.w = pk2(silu_f(a1[2]) * b1[2], silu_f(a1[3]) * b1[3]);
                *(u32x4*)rowp = o; }
    }
};
struct EpiResid {
    const float* hin_lat; float* hout_lat; float* part; const float* gate; float scale;
    __device__ __forceinline__ void operator()(const f32x4 (&acc)[2][2][4][2], const Unit& u, int wr, int wc, int fr, int fq) const {
        const int r0 = u.pm * BM; const bool isctx = r0 >= ML; const int bidx = isctx ? 8 : (r0 >> 12);
        const float* gr = gate + (size_t)bidx * NMOD;
        const int col0 = u.pn * BM + wc * 32 + 4 * fq;
        f32x4 gv[2][2];
#pragma unroll
        for (int bj = 0; bj < 2; ++bj)
#pragma unroll
            for (int n = 0; n < 2; ++n) gv[bj][n] = *(const f32x4*)(gr + col0 + bj * HALF + n * 16) * scale;
        const size_t rowoff = (size_t)(wr * 64 + fr) * D + col0;
        if (isctx) {
            float* ho = part + ((size_t)(u.ks & 3) * MC + (r0 - ML)) * D + rowoff;
#pragma unroll
            for (int ai = 0; ai < 2; ++ai)
#pragma unroll
                for (int m = 0; m < 4; ++m)
#pragma unroll
                    for (int bj = 0; bj < 2; ++bj)
#pragma unroll
                        for (int n = 0; n < 2; ++n) *(f32x4*)(ho + (size_t)(ai * HALF + m * 16) * D + bj * HALF + n * 16) = gv[bj][n] * acc[ai][bj][m][n];
        } else {
            const float* hi = hin_lat + (size_t)r0 * D + rowoff; float* ho = hout_lat + (size_t)r0 * D + rowoff;
#pragma unroll
            for (int ai = 0; ai < 2; ++ai) {
                f32x4 hv[4][2][2];
#pragma unroll
                for (int m = 0; m < 4; ++m)
#pragma unroll
                    for (int bj = 0; bj < 2; ++bj)
#pragma unroll
                        for (int n = 0; n < 2; ++n) hv[m][bj][n] = *(const f32x4*)(hi + (size_t)(ai * HALF + m * 16) * D + bj * HALF + n * 16);
#pragma unroll
                for (int m = 0; m < 4; ++m)
#pragma unroll
                    for (int bj = 0; bj < 2; ++bj)
#pragma unroll
                        for (int n = 0; n < 2; ++n) *(f32x4*)(ho + (size_t)(ai * HALF + m * 16) * D + bj * HALF + n * 16) = hv[m][bj][n] + gv[bj][n] * acc[ai][bj][m][n];
            }
        }
    }
};
struct EpiInproj {
    bf16_t* Z; bf16_t* Zt; bf16_t* Ztc;
    __device__ __forceinline__ void operator()(const f32x4 (&acc)[2][2][4][2], const Unit& u, int wr, int wc, int fr, int fq) const {
        const int r0 = u.pm * BM; const bool isctx = r0 >= ML;
        if (u.pn < 2) {
            const int part = u.pn;
#pragma unroll
            for (int ai = 0; ai < 2; ++ai)
#pragma unroll
                for (int m = 0; m < 4; ++m) { const int r = r0 + ai * HALF + wr * 64 + m * 16 + fr;
                    bf16_t* base; size_t stride;
                    if (!isctx) { const int b = r >> 12, l = r & 4095; base = Zt + (size_t)b * 256 * 8192 + part * 4096 + l; stride = 8192; }
                    else { const int rc = r - ML, b = rc >> 8, l = rc & 255; base = Ztc + (size_t)b * 256 * 512 + part * 256 + l; stride = 512; }
#pragma unroll
                    for (int bj = 0; bj < 2; ++bj)
#pragma unroll
                        for (int n = 0; n < 2; ++n) { const int hd = bj * HALF + wc * 32 + n * 16 + 4 * fq;
#pragma unroll
                            for (int e = 0; e < 4; ++e) base[(size_t)(hd + e) * stride] = f2bf(acc[ai][bj][m][n][e]); } }
        } else {
            const int colt = (u.pn - 2) * BM + wc * 32 + 4 * fq;
#pragma unroll
            for (int ai = 0; ai < 2; ++ai)
#pragma unroll
                for (int m = 0; m < 4; ++m) { const int r = r0 + ai * HALF + wr * 64 + m * 16 + fr; bf16_t* rowp = Z + (size_t)r * ZW;
#pragma unroll
                    for (int bj = 0; bj < 2; ++bj)
#pragma unroll
                        for (int n = 0; n < 2; ++n) { const int col = colt + bj * HALF + n * 16;
                            if (col < ZW) { const f32x4 v = acc[ai][bj][m][n]; u32x2 o; o.x = pk2(v[0], v[1]); o.y = pk2(v[2], v[3]); *(u32x2*)(rowp + col) = o; } } }
        }
    }
};
struct EpiQkv {
    bf16_t* Q; bf16_t* Kb; bf16_t* Vt; float qscale;
    __device__ __forceinline__ void operator()(const f32x4 (&acc)[2][2][4][2], const Unit& u, int wr, int wc, int fr, int fq) const {
        const int r0 = u.pm * BM; const bool isctx = r0 >= ML;
        if (u.pn < 2 && wc == 3) return;
#pragma unroll
        for (int ai = 0; ai < 2; ++ai)
#pragma unroll
            for (int m = 0; m < 4; ++m) {
                __builtin_amdgcn_sched_barrier(0);
                const int r = r0 + ai * HALF + wr * 64 + m * 16 + fr;
                int b, pos; if (!isctx) { b = r >> 12; pos = r & 4095; } else { const int rc = r - ML; b = rc >> 8; pos = SEQ + (rc & 255); }
#pragma unroll
                for (int bj = 0; bj < 2; ++bj) {
                    const int h = (u.pn & 1) * 2 + bj;
                    if (u.pn < 2 || wc < 2) {
                        bf16_t* qp = (u.pn < 2 ? Q : Kb) + ((size_t)(b * 4 + h) * NKEY + pos) * 96 + wc * 32 + 4 * fq; const float sc = u.pn < 2 ? qscale : 1.f;
#pragma unroll
                        for (int n = 0; n < 2; ++n) { const f32x4 v = acc[ai][bj][m][n] * sc; u32x2 o; o.x = pk2(v[0], v[1]); o.y = pk2(v[2], v[3]); *(u32x2*)(qp + n * 16) = o; }
                    } else {
                        bf16_t* vp = Vt + ((size_t)(b * 4 + h) * 64 + (wc - 2) * 32 + 4 * fq) * NKEY + pos;
#pragma unroll
                        for (int n = 0; n < 2; ++n)
#pragma unroll
                            for (int e = 0; e < 4; ++e) vp[(size_t)(n * 16 + e) * NKEY] = f2bf(acc[ai][bj][m][n][e]);
                    }
                }
            }
    }
};
struct EpiFourier {
    bf16_t* ymix; int rowbase0, rows_per_b;
    __device__ __forceinline__ void operator()(const f32x4 (&acc)[2][2][4][2], const Unit& u, int wr, int wc, int fr, int fq) const {
        const int b = u.pn;
#pragma unroll
        for (int ai = 0; ai < 2; ++ai)
#pragma unroll
            for (int m = 0; m < 4; ++m) { const int k = u.pm * BM + ai * HALF + wr * 64 + m * 16 + fr; bf16_t* rowp = ymix + (size_t)(rowbase0 + b * rows_per_b + k) * D + wc * 32 + 4 * fq;
#pragma unroll
                for (int bj = 0; bj < 2; ++bj)
#pragma unroll
                    for (int n = 0; n < 2; ++n) { const f32x4 v = acc[ai][bj][m][n]; u32x2 o; o.x = pk2(v[0], v[1]); o.y = pk2(v[2], v[3]); *(u32x2*)(rowp + bj * HALF + n * 16) = o; } }
    }
};

struct EpiF32 {
    float* C; int M;
    __device__ __forceinline__ void operator()(const f32x4 (&acc)[2][2][4][2], const Unit& u, int wr, int wc, int fr, int fq) const {
        float* base = C + ((size_t)u.pn * M + (size_t)u.pm * BM + wr * 64 + fr) * 256 + wc * 32 + 4 * fq;
#pragma unroll
        for (int ai = 0; ai < 2; ++ai)
#pragma unroll
            for (int m = 0; m < 4; ++m)
#pragma unroll
                for (int bj = 0; bj < 2; ++bj)
#pragma unroll
                    for (int n = 0; n < 2; ++n) *(f32x4*)(base + (size_t)(ai * HALF + m * 16) * 256 + bj * HALF + n * 16) = acc[ai][bj][m][n];
    }
};

__device__ __forceinline__ void fourier_pre(const int tid, const int bid, const int G, const bf16_t* __restrict__ ZT, bf16_t* __restrict__ FE, bf16_t* __restrict__ FO, float* __restrict__ FX) {
    const int lane = tid & 63, gw = bid * 8 + (tid >> 6), NGW = G * 8;
    for (int row = gw; row < NB * 256; row += NGW) {
        const bf16_t* zc = ZT + (size_t)row * 8192; const bf16_t* zs = zc + 4096; float alt = 0.f;
        u32x4 cv[4], sv[4], cA[4], sA[4]; unsigned cB[4], sB[4];
#pragma unroll
        for (int j = 0; j < 4; ++j) { const int l0 = 8 * (lane + 64 * j);
            cv[j] = *(const u32x4*)(zc + l0); sv[j] = *(const u32x4*)(zs + l0); cA[j] = *(const u32x4*)(zc + 4096 - l0 - 8); sA[j] = *(const u32x4*)(zs + 4096 - l0 - 8);
            cB[j] = *(const unsigned*)(zc + 4096 - l0); sB[j] = *(const unsigned*)(zs + 4096 - l0); }
        const float z2048 = bf2f(zc[2048]);
#pragma unroll
        for (int j = 0; j < 4; ++j) { const int l0 = 8 * (lane + 64 * j);
            const unsigned cw[4] = {cv[j].x, cv[j].y, cv[j].z, cv[j].w}, sw[4] = {sv[j].x, sv[j].y, sv[j].z, sv[j].w}, ca[4] = {cA[j].x, cA[j].y, cA[j].z, cA[j].w}, sa[4] = {sA[j].x, sA[j].y, sA[j].z, sA[j].w};
            float e8[8], o8[8];
#pragma unroll
            for (int e = 0; e < 8; ++e) { const float c = bf2f((e & 1) ? (cw[e >> 1] >> 16) : (cw[e >> 1] & 0xffffu)), s = bf2f((e & 1) ? (sw[e >> 1] >> 16) : (sw[e >> 1] & 0xffffu));
                float cm, sm;
                if (e == 0) { cm = bf2f(cB[j] & 0xffffu); sm = bf2f(sB[j] & 0xffffu); if (l0 == 0) { cm = 0.f; sm = s; } }
                else { const int m = 8 - e; cm = bf2f((m & 1) ? (ca[m >> 1] >> 16) : (ca[m >> 1] & 0xffffu)); sm = bf2f((m & 1) ? (sa[m >> 1] >> 16) : (sa[m >> 1] & 0xffffu)); }
                e8[e] = c + cm; o8[e] = s - sm; alt += (e & 1) ? -e8[e] : e8[e]; }
            u32x4 eo; eo.x = pk2(e8[0], e8[1]); eo.y = pk2(e8[2], e8[3]); eo.z = pk2(e8[4], e8[5]); eo.w = pk2(e8[6], e8[7]);
            u32x4 oo; oo.x = pk2(o8[0], o8[1]); oo.y = pk2(o8[2], o8[3]); oo.z = pk2(o8[4], o8[5]); oo.w = pk2(o8[6], o8[7]);
            *(u32x4*)(FE + (size_t)row * 2048 + l0) = eo; *(u32x4*)(FO + (size_t)row * 2048 + l0) = oo; }
        alt = wave_sum(alt) + z2048;
        if (lane == 0) { FX[row * 2] = alt; FX[row * 2 + 1] = z2048; }
    }
}
__device__ __forceinline__ void fourier_post(const int tid, const int bid, const int G, const float* __restrict__ CE, const float* __restrict__ SO, const float* __restrict__ FX, bf16_t* __restrict__ ymix) {
    const int gt = bid * 512 + tid, gs = G * 512;
    for (int it0 = gt; it0 < NB * 2048 * 64; it0 += 4 * gs) {
        f32x4 ce[4], so[4]; float fz[4][4], fr[4][4];
#pragma unroll
        for (int q = 0; q < 4; ++q) { const int it = it0 + q * gs; const int itc = it < NB * 2048 * 64 ? it : it0; const int hd = (itc & 63) * 4, k = (itc >> 6) & 2047, b = itc >> 17;
            ce[q] = *(const f32x4*)(CE + ((size_t)b * 2048 + k) * 256 + hd); so[q] = *(const f32x4*)(SO + ((size_t)b * 2048 + k) * 256 + hd);
#pragma unroll
            for (int e = 0; e < 4; ++e) { fz[q][e] = FX[(b * 256 + hd + e) * 2 + 1]; fr[q][e] = FX[(b * 256 + hd + e) * 2]; } }
#pragma unroll
        for (int q = 0; q < 4; ++q) { const int it = it0 + q * gs; if (it >= NB * 2048 * 64) break; const int hd = (it & 63) * 4, k = (it >> 6) & 2047, b = it >> 17;
            const float sg = (k & 1) ? (-1.f / 512.f) : (1.f / 512.f); f32x4 z2, r2;
#pragma unroll
            for (int e = 0; e < 4; ++e) { z2[e] = fz[q][e] * sg; r2[e] = fr[q][e] * (1.f / 512.f); }
            const f32x4 cz = ce[q] + z2, lo = cz - so[q], hi = cz + so[q];
            u32x2 o; o.x = pk2(lo[0], lo[1]); o.y = pk2(lo[2], lo[3]); *(u32x2*)(ymix + ((size_t)b * SEQ + k) * D + hd) = o;
            if (k) { o.x = pk2(hi[0], hi[1]); o.y = pk2(hi[2], hi[3]); *(u32x2*)(ymix + ((size_t)b * SEQ + SEQ - k) * D + hd) = o; }
            else { o.x = pk2(r2[0], r2[1]); o.y = pk2(r2[2], r2[3]); *(u32x2*)(ymix + ((size_t)b * SEQ + 2048) * D + hd) = o; }
        }
    }
}

__device__ __forceinline__ int rowmap13(int n) { const int s = n >= DFF; const int nn = n - s * DFF; const int r = (nn >> 7) * 256 + s * 128 + (nn & 127), c = r & 31;
    return (r & ~31) + ((c >> 2) & 1) * 16 + (c >> 3) * 4 + (c & 3); }
__device__ __forceinline__ void tr_item(const float* W, int N, int ncol0, int nblk, bf16_t* WT, int ldd, int mode, int row_off, LAS float* scr, int item, int lane) {
    const int kb = item / nblk, nb = item % nblk, k0 = 64 * kb, n0 = ncol0 + 32 * nb;
    float tv[32];
#pragma unroll
    for (int i = 0; i < 32; ++i) tv[i] = W[(size_t)(k0 + 2 * i + (lane >> 5)) * N + n0 + (lane & 31)];
#pragma unroll
    for (int i = 0; i < 32; ++i) scr[(2 * i + (lane >> 5)) * 33 + (lane & 31)] = tv[i];
    LDS_WAIT();
    const int c = lane & 7;
#pragma unroll
    for (int j = 0; j < 4; ++j) { const int n = (lane >> 3) + 8 * j; const LAS float* s = scr + (8 * c) * 33 + n;
        u32x4 o; o.x = pk2(s[0 * 33], s[1 * 33]); o.y = pk2(s[2 * 33], s[3 * 33]); o.z = pk2(s[4 * 33], s[5 * 33]); o.w = pk2(s[6 * 33], s[7 * 33]);
        const int drow = mode ? rowmap13(n0 + n) : row_off + (n0 - ncol0) + n;
        *(u32x4*)(WT + (size_t)drow * ldd + k0 + 8 * c) = o; }
    LDS_WAIT();
}
__device__ __forceinline__ void weight_transposes(CP* pp, LAS unsigned char* lds, const int layer, const int gw, const int NGW, const int wid, const int lane) {
    LAS float* scr = (LAS float*)(lds + wid * 8448);
    constexpr int I13 = 16 * 176, I2 = 44 * 32, IIN = 16 * 27, IOUT = 16 * 32, ILAY = 2 * I13 + 2 * I2 + IIN + IOUT;
    unsigned char* wl = pp->ws + O_W + (size_t)layer * W_LAYER;
    for (int it = gw; it < ILAY; it += NGW) {
        int r = it;
        if (r < I13) { tr_item(pp->in[I_W13A] + (size_t)layer * D * 2 * DFF, 2 * DFF, 0, 176, (bf16_t*)(wl + W_13A), D, 1, 0, scr, r, lane); continue; } r -= I13;
        if (r < I13) { tr_item(pp->in[I_W13B] + (size_t)layer * D * 2 * DFF, 2 * DFF, 0, 176, (bf16_t*)(wl + W_13B), D, 1, 0, scr, r, lane); continue; } r -= I13;
        if (r < I2) { tr_item(pp->in[I_W2A] + (size_t)layer * DFF * D, D, 0, 32, (bf16_t*)(wl + W_2A), DFF, 0, 0, scr, r, lane); continue; } r -= I2;
        if (r < I2) { tr_item(pp->in[I_W2B] + (size_t)layer * DFF * D, D, 0, 32, (bf16_t*)(wl + W_2B), DFF, 0, 0, scr, r, lane); continue; } r -= I2;
        if (r < IIN) { tr_item(pp->in[I_WIN] + (size_t)layer * D * 1376, 1376, 256, 27, (bf16_t*)(wl + W_IN), D, 0, 512, scr, r, lane); continue; } r -= IIN;
        tr_item(pp->in[I_WOUT] + (size_t)layer * D * D, D, 0, 32, (bf16_t*)(wl + W_OUT), D, 0, 0, scr, r, lane);
    }
}
__device__ __forceinline__ void phase0(const int tid, const int bid, const int G, CP* pp, LAS unsigned char* lds) {
    const int wid = tid >> 6, lane = tid & 63;
    unsigned char* ws = pp->ws;
    weight_transposes(pp, lds, 0, bid * 8 + wid, G * 8, wid, lane);
    __syncthreads();
    {
        const size_t gt = (size_t)bid * 512 + tid, gs = (size_t)G * 512;
        bf16_t* dft = (bf16_t*)(ws + O_DFT);
        for (size_t ch = gt; ch < (size_t)2 * 2048 * 256; ch += gs) {
            const int part = (int)(ch >> 19), k = (int)(ch >> 8) & 2047, l0 = (int)(ch & 255) * 8; float v[8];
#pragma unroll
            for (int e = 0; e < 8; ++e) { const float x = (float)((k * (l0 + e)) & 4095) * (1.f / 4096.f); v[e] = (part ? __builtin_amdgcn_sinf(x) : __builtin_amdgcn_cosf(x)) * (1.f / 512.f); }
            u32x4 o; o.x = pk2(v[0], v[1]); o.y = pk2(v[2], v[3]); o.z = pk2(v[4], v[5]); o.w = pk2(v[6], v[7]);
            *(u32x4*)(dft + (size_t)ch * 8) = o;
        }
        bf16_t* dftc = (bf16_t*)(ws + O_DFTC);
        for (size_t i = gt; i < (size_t)256 * 512; i += gs) { const int k = (int)(i >> 9), col = (int)(i & 511), part = col >> 8, l = col & 255;
            const float x = (float)((k * l) & 255) * (1.f / 256.f); dftc[i] = f2bf((part ? -__builtin_amdgcn_sinf(x) : __builtin_amdgcn_cosf(x)) * (1.f / 128.f)); }
        for (int layer = 0; layer < 2; ++layer) {
            unsigned char* wl = ws + O_W + (size_t)layer * W_LAYER;
            bf16_t* wq = (bf16_t*)(wl + W_QKV); const float* wuq = pp->in[I_WUQ] + (size_t)layer * 192 * 384; const float* wukv = pp->in[I_WUKV] + (size_t)layer * 128 * 512;
            for (size_t i = gt; i < (size_t)1024 * KQ; i += gs) { const int n = (int)(i / KQ), k = (int)(i % KQ); float val = 0.f;
                if (n < 512) { const int h = n >> 7, c = n & 127;
                    if (c < 96) { int sd = c; if (c >= 64) { const int c2 = c - 64, nn = c2 >> 4, ii = c2 & 15; sd = 64 + (ii >> 3) * 16 + nn * 8 + (ii & 7); } if (k < 192) val = wuq[(size_t)k * 384 + h * 96 + sd]; }
                } else { const int n2 = n - 512; if (k >= 192 && k < 320) val = wukv[(size_t)(k - 192) * 512 + n2]; }
                wq[i] = f2bf(val); }
            bf16_t* wsb = (bf16_t*)(wl + W_S); const float* wsg = pp->in[I_WSGU] + (size_t)layer * 4 * 128 * 128;
            for (size_t i = gt; i < (size_t)4 * 128 * 128; i += gs) wsb[i] = f2bf(wsg[i]);
        }
    }
    {
        LAS float* T = (LAS float*)(lds + 122880);
        LAS float* Wl = (LAS float*)(lds + 67584);
        LAS float* wfl = (LAS float*)(lds + 100352);
        LAS float* tab = (LAS float*)(lds + 116736);
        constexpr int NF = 2 * 2 * 4 * 8, NPL = 2 * 4 * 8;
        for (int it = bid; it < NF + NPL; it += G) {
            int layer, srccol, destrow, kch, part = 0; const bool four = it < NF;
            if (four) { layer = it >> 6; part = (it >> 5) & 1; const int h = (it >> 3) & 3; kch = it & 7; srccol = h * 64; destrow = part * 256 + h * 64; }
            else { const int r = it - NF; layer = r >> 5; const int g = (r >> 3) & 3; kch = r & 7; srccol = 1120 + g * 64; destrow = 512 + 864 + g * 64; }
            const float* win = pp->in[I_WIN] + (size_t)layer * D * 1376;
            __syncthreads();
            for (int i = tid; i < 2048; i += 512) { const int row = i >> 4, c4 = i & 15; *(LAS f32x4*)(Wl + row * 64 + c4 * 4) = *(const f32x4*)(win + (size_t)(kch * 128 + row) * 1376 + srccol + c4 * 4); }
            if (four) { const float* wf = pp->in[I_WF] + (size_t)(layer * 4 + (srccol >> 6)) * 4096;
                for (int i = tid; i < 1024; i += 512) *(LAS f32x4*)(wfl + i * 4) = *(const f32x4*)(wf + i * 4);
                if (tid < 64) { const float x = (float)tid * (1.f / 64.f); tab[tid] = part ? __builtin_amdgcn_sinf(x) : __builtin_amdgcn_cosf(x); }
                __syncthreads();
                for (int idx = tid; idx < 4096; idx += 512) { const int c = idx >> 6, d = idx & 63; float s = 0.f;
#pragma unroll 16
                    for (int j = 0; j < 64; ++j) s += tab[(j * c) & 63] * wfl[j * 64 + d];
                    T[idx] = s; }
            } else { const int g = (srccol - 1120) >> 6; const float* wp = pp->in[I_WP] + (size_t)(layer * 4 + g) * 4096; const float* sp = pp->in[I_SP] + layer * 256 + g * 64;
                for (int idx = tid; idx < 4096; idx += 512) T[idx] = wp[idx] * sp[idx & 63]; }
            __syncthreads();
            bf16_t* wint = (bf16_t*)(ws + O_W + (size_t)layer * W_LAYER + W_IN);
            const int d = tid & 63, ks = tid >> 6;
            float Tr[64];
#pragma unroll
            for (int c = 0; c < 64; ++c) Tr[c] = T[c * 64 + d];
            for (int i = 0; i < 16; ++i) { const int kk = ks + 8 * i; float s = 0.f;
#pragma unroll
                for (int c4 = 0; c4 < 16; ++c4) { const f32x4 w = *(const LAS f32x4*)(Wl + kk * 64 + c4 * 4); s += w[0] * Tr[4 * c4] + w[1] * Tr[4 * c4 + 1] + w[2] * Tr[4 * c4 + 2] + w[3] * Tr[4 * c4 + 3]; }
                wint[(size_t)(destrow + d) * D + kch * 128 + kk] = f2bf(s); }
        }
        __syncthreads();
    }
    {
        LAS float* sc = (LAS float*)(lds);
        LAS float* red = (LAS float*)(lds + 36864);
        for (int idx = tid; idx < 9 * D; idx += 512) { const int r = idx >> 10, k = idx & 1023; const float v = r < 8 ? pp->in[I_C][r * D + k] : pp->in[I_CCTX][k]; sc[idx] = v / (1.f + expf(-v)); }
        __syncthreads();
        float* mod = (float*)(ws + O_MOD);
        for (int it = (bid + 64) % G; it < 2 * 144; it += G) {
            const int layer = it / 144, n0 = (it % 144) * 64, col = tid & 63, kg = tid >> 6;
            const float* wa = pp->in[I_WADA] + (size_t)layer * D * NMOD + n0 + col;
            float a[9];
#pragma unroll
            for (int r = 0; r < 9; ++r) a[r] = 0.f;
            for (int k0 = kg * 128; k0 < kg * 128 + 128; k0 += 16) { float w[16];
#pragma unroll
                for (int u = 0; u < 16; ++u) w[u] = wa[(size_t)(k0 + u) * NMOD];
#pragma unroll
                for (int r = 0; r < 9; ++r)
#pragma unroll
                    for (int u4 = 0; u4 < 4; ++u4) { const f32x4 s4 = *(const LAS f32x4*)(sc + r * D + k0 + 4 * u4); a[r] += s4[0] * w[4 * u4] + s4[1] * w[4 * u4 + 1] + s4[2] * w[4 * u4 + 2] + s4[3] * w[4 * u4 + 3]; } }
#pragma unroll
            for (int r = 0; r < 9; ++r) red[(kg * 9 + r) * 64 + col] = a[r];
            __syncthreads();
            for (int idx = tid; idx < 576; idx += 512) { const int r = idx >> 6, cc = idx & 63; float s = pp->in[I_BADA][layer * NMOD + n0 + cc];
#pragma unroll
                for (int g2 = 0; g2 < 8; ++g2) s += red[(g2 * 9 + r) * 64 + cc];
                mod[(size_t)(layer * 9 + r) * NMOD + n0 + cc] = s; }
            __syncthreads();
        }
    }
}

__device__ __forceinline__ void norm_phase(const int tid, const int bid, const int G, const float* src_lat, const float* src_ctx, int nrows, const float* g, const float* modl, int ishift, int iscale, bf16_t* dst, const float* part, float* hc_out) {
    const int lane = tid & 63, gw = bid * 8 + (tid >> 6), NGW = G * 8;
    f32x4 gg[4];
#pragma unroll
    for (int j = 0; j < 4; ++j) gg[j] = *(const f32x4*)(g + 4 * lane + 256 * j);
    for (int rb = gw; rb < nrows; rb += 2 * NGW) {
        f32x4 v[2][4]; f32x4 pa[2][4]; f32x4 scv[2][4], shv[2][4];
#pragma unroll
        for (int q = 0; q < 2; ++q) { const int r = rb + q * NGW; const bool on = r < nrows; const int rr = on ? r : rb;
            const float* src = rr < ML ? src_lat + (size_t)rr * D : src_ctx + (size_t)(rr - ML) * D; const bool fold = (rr >= ML) && (part != nullptr);
            const float* mr0 = modl + (size_t)(rr < ML ? (rr >> 12) : 8) * NMOD;
#pragma unroll
            for (int j = 0; j < 4; ++j) { v[q][j] = ((const f32x4*)src)[lane + 64 * j]; scv[q][j] = *(const f32x4*)(mr0 + iscale * D + 4 * lane + 256 * j); shv[q][j] = *(const f32x4*)(mr0 + ishift * D + 4 * lane + 256 * j);
                pa[q][j] = (f32x4){0.f, 0.f, 0.f, 0.f};
                if (fold) { const f32x4* pq = (const f32x4*)(part + (size_t)(rr - ML) * D) + lane + 64 * j; pa[q][j] = (pq[0] + pq[(size_t)MC * D / 4]) + (pq[(size_t)2 * MC * D / 4] + pq[(size_t)3 * MC * D / 4]); } } }
#pragma unroll
        for (int q = 0; q < 2; ++q) { const int r = rb + q * NGW; if (r >= nrows) break; float ss = 0.f;
#pragma unroll
            for (int j = 0; j < 4; ++j) { v[q][j] = v[q][j] + pa[q][j]; ss += v[q][j][0] * v[q][j][0] + v[q][j][1] * v[q][j][1] + v[q][j][2] * v[q][j][2] + v[q][j][3] * v[q][j][3]; }
            if (r >= ML) {
#pragma unroll
                for (int j = 0; j < 4; ++j) ((f32x4*)(hc_out + (size_t)(r - ML) * D))[lane + 64 * j] = v[q][j]; }
            const float rstd = rsqrtf(wave_sum(ss) * (1.f / D) + 1e-6f);
#pragma unroll
            for (int j = 0; j < 4; ++j) { const int c = 4 * lane + 256 * j;
                const f32x4 y = v[q][j] * rstd * gg[j] * (scv[q][j] + 1.f) + shv[q][j]; u32x2 o; o.x = pk2(y[0], y[1]); o.y = pk2(y[2], y[3]); *(u32x2*)(dst + (size_t)r * D + c) = o; }
        }
    }
}
__device__ __forceinline__ void final_norm(const int tid, const int bid, const int G, float* h, const float* g) {
    const int lane = tid & 63, gw = bid * 8 + (tid >> 6), NGW = G * 8;
    f32x4 gg[4];
#pragma unroll
    for (int j = 0; j < 4; ++j) gg[j] = *(const f32x4*)(g + 4 * lane + 256 * j);
    for (int rb = gw; rb < ML; rb += 2 * NGW) {
        f32x4 v[2][4];
#pragma unroll
        for (int q = 0; q < 2; ++q) { const int r = rb + q * NGW; const int rr = r < ML ? r : rb;
#pragma unroll
            for (int j = 0; j < 4; ++j) v[q][j] = ((const f32x4*)(h + (size_t)rr * D))[lane + 64 * j]; }
#pragma unroll
        for (int q = 0; q < 2; ++q) { const int r = rb + q * NGW; if (r >= ML) break; float ss = 0.f;
#pragma unroll
            for (int j = 0; j < 4; ++j) ss += v[q][j][0] * v[q][j][0] + v[q][j][1] * v[q][j][1] + v[q][j][2] * v[q][j][2] + v[q][j][3] * v[q][j][3];
            const float rstd = rsqrtf(wave_sum(ss) * (1.f / D) + 1e-6f);
#pragma unroll
            for (int j = 0; j < 4; ++j) ((f32x4*)(h + (size_t)r * D))[lane + 64 * j] = v[q][j] * rstd * gg[j];
        }
    }
}

__device__ __forceinline__ void prep_pool_phase(const int tid, const int bid, const int G, const bf16_t* __restrict__ Z, bf16_t* __restrict__ AQ, bf16_t* __restrict__ Kb, bf16_t* __restrict__ ymix, const float* __restrict__ gq, const float* __restrict__ gkv, int nrows, int nrows_pool) {
    const int lane = tid & 63, gw = bid * 8 + (tid >> 6), NGW = G * 8;
    for (int r = gw; r < nrows; r += NGW) {
        const bf16_t* zr = Z + (size_t)r * ZW; bf16_t* ar = AQ + (size_t)r * KQ;
        const int l32 = lane & 31;
        const bf16_t rx0 = zr[lane], rx1 = zr[64 + lane], rx2 = zr[128 + lane], ry0 = zr[192 + lane], ry1 = zr[256 + lane], rkr = zr[320 + l32];
        const bool dopool = r < nrows_pool;
        int t, Ls, seqbase; if (r < ML) { t = r & 4095; Ls = SEQ; seqbase = r & ~4095; } else { const int rc = r - ML; t = rc & 255; Ls = CTX; seqbase = ML + (rc & ~255); }
        const int gi = lane >> 4, w = 2 << gi; int lo = t - (w >> 1), hi = lo + w; lo = lo < 0 ? 0 : lo; hi = hi > Ls ? Ls : hi;
        u32x2 qq[16]; u32x2 qc = {0u, 0u};
        if (dopool) {
#pragma unroll
            for (int j = 0; j < 16; ++j) { int tp = t - 8 + j; tp = tp < lo ? lo : (tp >= hi ? hi - 1 : tp); qq[j] = *(const u32x2*)(Z + (size_t)(seqbase + tp) * ZW + 864 + 4 * lane); }
            qc = *(const u32x2*)(zr + 864 + 4 * lane);
        }
        const float g0 = gq[lane], g1 = gq[64 + lane], g2 = gq[128 + lane], k0 = gkv[lane], k1 = gkv[64 + lane];
        const float x0 = bf2f(rx0), x1 = bf2f(rx1), x2 = bf2f(rx2), y0 = bf2f(ry0), y1 = bf2f(ry1);
        const float rq = rsqrtf(wave_sum(x0 * x0 + x1 * x1 + x2 * x2) * (1.f / 192.f) + 1e-6f);
        const float rk = rsqrtf(wave_sum(y0 * y0 + y1 * y1) * (1.f / 128.f) + 1e-6f);
        ar[lane] = f2bf(x0 * rq * g0); ar[64 + lane] = f2bf(x1 * rq * g1); ar[128 + lane] = f2bf(x2 * rq * g2);
        ar[192 + lane] = f2bf(y0 * rk * k0); ar[256 + lane] = f2bf(y1 * rk * k1);
        ar[320 + lane] = 0;
        {
            const int axis = l32 >> 4, half = (l32 >> 3) & 1, ii = l32 & 7;
            const float x = bf2f(rkr), xp = __shfl_xor(x, 8); float o = x; int b, pos;
            if (r < ML) { b = r >> 12; pos = r & 4095; const float posax = (float)(axis ? (pos & 63) : (pos >> 6));
                float rev = posax * __builtin_amdgcn_exp2f(-1.6609640474436811f * (float)ii) * 0.15915494309189535f; rev -= floorf(rev);
                const float c = __builtin_amdgcn_cosf(rev), s = __builtin_amdgcn_sinf(rev); o = half ? (xp * s + x * c) : (x * c - xp * s); }
            else { const int rc = r - ML; b = rc >> 8; pos = SEQ + (rc & 255); }
            if (lane < 32) { const bf16_t ob = f2bf(o); const int dd = 64 + half * 16 + axis * 8 + ii;
#pragma unroll
                for (int hh = 0; hh < 4; ++hh) Kb[((size_t)(b * 4 + hh) * NKEY + pos) * 96 + dd] = ob; }
        }
        if (dopool) {
            float s0 = 0.f, s1 = 0.f, s2 = 0.f, s3 = 0.f;
#pragma unroll
            for (int j = 0; j < 16; ++j) { const int tp = t - 8 + j; const bool ok = tp >= lo && tp < hi;
                s0 += ok ? bf2f(qq[j].x & 0xffffu) : 0.f; s1 += ok ? bf2f(qq[j].x >> 16) : 0.f; s2 += ok ? bf2f(qq[j].y & 0xffffu) : 0.f; s3 += ok ? bf2f(qq[j].y >> 16) : 0.f; }
            const float inv = 1.f / (float)(hi - lo);
            u32x2 o; o.x = pk2(s0 * inv - bf2f(qc.x & 0xffffu), s1 * inv - bf2f(qc.x >> 16)); o.y = pk2(s2 * inv - bf2f(qc.y & 0xffffu), s3 * inv - bf2f(qc.y >> 16));
            *(u32x2*)(ymix + (size_t)r * D + 768 + 4 * lane) = o;
        }
    }
}

__device__ __forceinline__ void sgu_phase(const int tid, const int bid, const int G, LAS unsigned char* lds, const bf16_t* Z, const float* gsgu, const bf16_t* wsb, const float* bsgu, bf16_t* ymix, int nchunks) {
    const int wid = tid >> 6, lane = tid & 63, n16 = lane & 15, q8 = lane >> 4;
    constexpr int VST = 272;
    for (int ch = bid; ch < nchunks; ch += G) {
        const int row0 = ch * 128;
        __syncthreads();
        { const int token = tid & 127, head = tid >> 7; const bf16_t* zr = Z + (size_t)(row0 + token) * ZW + 608 + head * 64;
            float v[64]; float ss = 0.f;
#pragma unroll
            for (int i = 0; i < 8; ++i) { const u32x4 q = *(const u32x4*)(zr + 8 * i); const unsigned w4[4] = {q.x, q.y, q.z, q.w};
#pragma unroll
                for (int e = 0; e < 4; ++e) { const float a = gelu_f(bf2f(w4[e] & 0xffffu)), b = gelu_f(bf2f(w4[e] >> 16)); v[8 * i + 2 * e] = a; v[8 * i + 2 * e + 1] = b; ss += a * a + b * b; } }
            const float rstd = rsqrtf(ss * (1.f / 64.f) + 1e-6f);
            f32x4 gs4[16];
#pragma unroll
            for (int c4 = 0; c4 < 16; ++c4) gs4[c4] = *(const f32x4*)(gsgu + head * 64 + 4 * c4);
#pragma unroll
            for (int c = 0; c < 64; ++c) *(LAS bf16_t*)(lds + (head * 64 + c) * VST + token * 2) = f2bf(v[c] * rstd * gs4[c >> 2][c & 3]);
        }
        __syncthreads();
        const int head = wid >> 1, phalf = wid & 1;
        bf16x8 Af[4][4];
#pragma unroll
        for (int ks = 0; ks < 4; ++ks)
#pragma unroll
            for (int pg = 0; pg < 4; ++pg) Af[ks][pg] = *(const bf16x8*)(wsb + (size_t)(head * 128 + phalf * 64 + pg * 16 + n16) * 128 + ks * 32 + q8 * 8);
        f32x4 acc[4][4];
#pragma unroll
        for (int a = 0; a < 4; ++a)
#pragma unroll
            for (int b = 0; b < 4; ++b) acc[a][b] = (f32x4){0.f, 0.f, 0.f, 0.f};
#pragma unroll
        for (int ks = 0; ks < 4; ++ks) {
            bf16x8 Bf[4];
#pragma unroll
            for (int cg2 = 0; cg2 < 4; ++cg2) Bf[cg2] = *(const LAS bf16x8*)(lds + (head * 64 + cg2 * 16 + n16) * VST + (ks * 32 + q8 * 8) * 2);
#pragma unroll
            for (int pg = 0; pg < 4; ++pg)
#pragma unroll
                for (int cg2 = 0; cg2 < 4; ++cg2) acc[pg][cg2] = __builtin_amdgcn_mfma_f32_16x16x32_bf16(Bf[cg2], Af[ks][pg], acc[pg][cg2], 0, 0, 0);
        }
        u32x2 uq[4][4]; float bias[4];
#pragma unroll
        for (int pg = 0; pg < 4; ++pg) { const int pp = phalf * 64 + pg * 16 + n16; bias[pg] = bsgu[head * 128 + pp];
#pragma unroll
            for (int cg2 = 0; cg2 < 4; ++cg2) uq[pg][cg2] = *(const u32x2*)(Z + (size_t)(row0 + pp) * ZW + 352 + head * 64 + cg2 * 16 + q8 * 4); }
#pragma unroll
        for (int pg = 0; pg < 4; ++pg) { const int pp = phalf * 64 + pg * 16 + n16, row = row0 + pp;
#pragma unroll
            for (int cg2 = 0; cg2 < 4; ++cg2) { const int c = head * 64 + cg2 * 16 + q8 * 4; const u32x2 q = uq[pg][cg2];
                const f32x4 a = acc[pg][cg2];
                u32x2 o; o.x = pk2(gelu_f(bf2f(q.x & 0xffffu)) * (a[0] + bias[pg]), gelu_f(bf2f(q.x >> 16)) * (a[1] + bias[pg])); o.y = pk2(gelu_f(bf2f(q.y & 0xffffu)) * (a[2] + bias[pg]), gelu_f(bf2f(q.y >> 16)) * (a[3] + bias[pg]));
                *(u32x2*)(ymix + (size_t)row * D + 512 + c) = o; } }
    }
    __syncthreads();
}

__device__ __forceinline__ void attn_phase(const int tid, const int bid, const int G, LAS unsigned char* lds, const bf16_t* Q, const bf16_t* Kb, const bf16_t* Vt, bf16_t* ymix, int with_ctx) {
    const int wid = tid >> 6, lane = tid & 63, n16 = lane & 15, q8 = lane >> 4;
    constexpr int KST = 208, VST = 144, KBUF = 64 * KST, VBUF = 64 * VST, BUF = KBUF + VBUF;
    const int vb = (G % 8 == 0) ? ((bid % 8) * (G / 8) + bid / 8) : bid;
    const int nunits = 512 + (with_ctx ? 32 : 0);
    for (int u = vb; u < nunits; u += G) {
        int b, h, q0, key0, nkeys, rowbase;
        if (u < 512) { b = u >> 6; h = (u >> 4) & 3; q0 = (u & 15) * 256; key0 = 0; nkeys = NKEY; rowbase = b * SEQ + q0; }
        else { const int uu = u - 512; b = uu >> 2; h = uu & 3; q0 = SEQ; key0 = SEQ; nkeys = CTX; rowbase = ML + b * CTX; }
        const int bh = b * 4 + h;
        const bf16_t* Qb = Q + ((size_t)bh * NKEY + q0 + wid * 32) * 96;
        bf16x8 Qf[2][3];
#pragma unroll
        for (int qg = 0; qg < 2; ++qg)
#pragma unroll
            for (int dc = 0; dc < 3; ++dc) Qf[qg][dc] = *(const bf16x8*)(Qb + (size_t)(qg * 16 + n16) * 96 + dc * 32 + q8 * 8);
        if (u < 512) {
#pragma unroll
            for (int qg = 0; qg < 2; ++qg) {
                const int pos = q0 + wid * 32 + qg * 16 + n16; const float posax = (float)((q8 & 1) ? (pos & 63) : (pos >> 6));
                const u32x4 me = __builtin_bit_cast(u32x4, Qf[qg][2]); u32x4 pa; pa.x = __shfl_xor(me.x, 32); pa.y = __shfl_xor(me.y, 32); pa.z = __shfl_xor(me.z, 32); pa.w = __shfl_xor(me.w, 32);
                const unsigned mw[4] = {me.x, me.y, me.z, me.w}, pw[4] = {pa.x, pa.y, pa.z, pa.w}; unsigned ow[4];
#pragma unroll
                for (int e = 0; e < 4; ++e) { float res[2];
#pragma unroll
                    for (int hf = 0; hf < 2; ++hf) { const int ii = 2 * e + hf; const float xm = bf2f(hf ? (mw[e] >> 16) : (mw[e] & 0xffffu)), xo = bf2f(hf ? (pw[e] >> 16) : (pw[e] & 0xffffu));
                        float rev = posax * __builtin_amdgcn_exp2f(-1.6609640474436811f * (float)ii) * 0.15915494309189535f; rev -= floorf(rev);
                        const float c = __builtin_amdgcn_cosf(rev), s = __builtin_amdgcn_sinf(rev);
                        res[hf] = (q8 < 2) ? (xm * c - xo * s) : (xo * s + xm * c); }
                    ow[e] = pk2(res[0], res[1]); }
                u32x4 ov; ov.x = ow[0]; ov.y = ow[1]; ov.z = ow[2]; ov.w = ow[3]; Qf[qg][2] = __builtin_bit_cast(bf16x8, ov);
            }
        }
        const bf16_t* Kg = Kb + ((size_t)bh * NKEY + key0) * 96; const bf16_t* Vg = Vt + (size_t)bh * 64 * NKEY + key0;
        const int ntiles = nkeys >> 6;
        const int kc0 = tid, kc1 = 512 + (tid & 255);
        const int klds0 = (kc0 / 12) * KST + (kc0 % 12) * 16, klds1 = (kc1 / 12) * KST + (kc1 % 12) * 16;
        const int vd = tid >> 3, vp = tid & 7, vlds = KBUF + vd * VST + vp * 16;
        u32x4 kr0, kr1, vr;
        kr0 = *(const u32x4*)(Kg + (size_t)kc0 * 8); kr1 = *(const u32x4*)(Kg + (size_t)kc1 * 8); vr = *(const u32x4*)(Vg + (size_t)vd * NKEY + vp * 8);
        __syncthreads();
        *(LAS u32x4*)(lds + klds0) = kr0; if (tid < 256) *(LAS u32x4*)(lds + klds1) = kr1; *(LAS u32x4*)(lds + vlds) = vr;
        __syncthreads();
        f32x4 O[5][2]; float mrun[2];
        const u32x4 onesw = {0x3F803F80u, 0x3F803F80u, 0x3F803F80u, 0x3F803F80u}; const bf16x8 ones = __builtin_bit_cast(bf16x8, onesw);
#pragma unroll
        for (int dg = 0; dg < 5; ++dg) { O[dg][0] = (f32x4){0.f, 0.f, 0.f, 0.f}; O[dg][1] = (f32x4){0.f, 0.f, 0.f, 0.f}; }
        mrun[0] = mrun[1] = -1e30f;
        for (int t = 0; t < ntiles; ++t) {
            const bool more = (t + 1 < ntiles);
            if (more) { const bf16_t* kn = Kg + (size_t)(t + 1) * 64 * 96; kr0 = *(const u32x4*)(kn + (size_t)kc0 * 8); kr1 = *(const u32x4*)(kn + (size_t)kc1 * 8); vr = *(const u32x4*)(Vg + (size_t)vd * NKEY + (t + 1) * 64 + vp * 8); }
            LAS unsigned char* kbuf = lds + (t & 1) * BUF; LAS unsigned char* vbuf = kbuf + KBUF;
            f32x4 S[4][2];
#pragma unroll
            for (int kg = 0; kg < 4; ++kg) {
                bf16x8 Kf[3];
#pragma unroll
                for (int dc = 0; dc < 3; ++dc) Kf[dc] = *(const LAS bf16x8*)(kbuf + (kg * 16 + n16) * KST + dc * 64 + q8 * 16);
#pragma unroll
                for (int qg = 0; qg < 2; ++qg) { f32x4 s = (f32x4){0.f, 0.f, 0.f, 0.f};
#pragma unroll
                    for (int dc = 0; dc < 3; ++dc) s = __builtin_amdgcn_mfma_f32_16x16x32_bf16(Kf[dc], Qf[qg][dc], s, 0, 0, 0);
                    S[kg][qg] = s; }
            }
            bf16x8 Pf[2][2];
#pragma unroll
            for (int qg = 0; qg < 2; ++qg) {
                if ((t & 7) == 0) {
                    float mx = fmaxf(fmaxf(S[0][qg][0], S[0][qg][1]), fmaxf(S[0][qg][2], S[0][qg][3]));
#pragma unroll
                    for (int kg = 1; kg < 4; ++kg) mx = fmaxf(mx, fmaxf(fmaxf(S[kg][qg][0], S[kg][qg][1]), fmaxf(S[kg][qg][2], S[kg][qg][3])));
                    mx = fmaxf(mx, __shfl_xor(mx, 16)); mx = fmaxf(mx, __shfl_xor(mx, 32));
                    const float mn = fmaxf(mrun[qg], mx), al = __builtin_amdgcn_exp2f(mrun[qg] - mn); mrun[qg] = mn;
#pragma unroll
                    for (int dg = 0; dg < 5; ++dg) O[dg][qg] = O[dg][qg] * al;
                }
                { const f32x2 m2 = {mrun[qg], mrun[qg]};
#pragma unroll
                    for (int kg = 0; kg < 4; ++kg) { f32x2 lo = {S[kg][qg][0], S[kg][qg][1]}, hi = {S[kg][qg][2], S[kg][qg][3]}; lo = lo - m2; hi = hi - m2;
                        S[kg][qg][0] = __builtin_amdgcn_exp2f(lo[0]); S[kg][qg][1] = __builtin_amdgcn_exp2f(lo[1]); S[kg][qg][2] = __builtin_amdgcn_exp2f(hi[0]); S[kg][qg][3] = __builtin_amdgcn_exp2f(hi[1]); } }
#pragma unroll
                for (int kt = 0; kt < 2; ++kt) { u32x4 pw; pw.x = pk2(S[2 * kt][qg][0], S[2 * kt][qg][1]); pw.y = pk2(S[2 * kt][qg][2], S[2 * kt][qg][3]);
                    pw.z = pk2(S[2 * kt + 1][qg][0], S[2 * kt + 1][qg][1]); pw.w = pk2(S[2 * kt + 1][qg][2], S[2 * kt + 1][qg][3]); Pf[qg][kt] = __builtin_bit_cast(bf16x8, pw); }
            }
#pragma unroll
            for (int dg = 0; dg < 4; ++dg)
#pragma unroll
                for (int kt = 0; kt < 2; ++kt) {
                    const u32x2 lo = *(const LAS u32x2*)(vbuf + (dg * 16 + n16) * VST + (kt * 32 + q8 * 4) * 2), hi = *(const LAS u32x2*)(vbuf + (dg * 16 + n16) * VST + (kt * 32 + 16 + q8 * 4) * 2);
                    u32x4 vw; vw.x = lo.x; vw.y = lo.y; vw.z = hi.x; vw.w = hi.y; const bf16x8 Vf = __builtin_bit_cast(bf16x8, vw);
#pragma unroll
                    for (int qg = 0; qg < 2; ++qg) O[dg][qg] = __builtin_amdgcn_mfma_f32_16x16x32_bf16(Vf, Pf[qg][kt], O[dg][qg], 0, 0, 0);
                }
#pragma unroll
            for (int kt = 0; kt < 2; ++kt)
#pragma unroll
                for (int qg = 0; qg < 2; ++qg) O[4][qg] = __builtin_amdgcn_mfma_f32_16x16x32_bf16(ones, Pf[qg][kt], O[4][qg], 0, 0, 0);
            if (more) { LAS unsigned char* nb = lds + ((t + 1) & 1) * BUF; *(LAS u32x4*)(nb + klds0) = kr0; if (tid < 256) *(LAS u32x4*)(nb + klds1) = kr1; *(LAS u32x4*)(nb + vlds) = vr; }
            __syncthreads();
        }
#pragma unroll
        for (int qg = 0; qg < 2; ++qg) { const float inv = 1.f / O[4][qg][0];
            bf16_t* op = ymix + (size_t)(rowbase + wid * 32 + qg * 16 + n16) * D + 256 + h * 64 + q8 * 4;
#pragma unroll
            for (int dg = 0; dg < 4; ++dg) { const f32x4 v = O[dg][qg] * inv; u32x2 o; o.x = pk2(v[0], v[1]); o.y = pk2(v[2], v[3]); *(u32x2*)(op + dg * 16) = o; } }
    }
}

#ifndef PHSEL
#define PHSEL 0xFFFFF
#endif
#define PHON(k) ((PHSEL >> (k)) & 1)
__device__ __forceinline__ void run_phase(const int tid, const int bid, const int G, CP* pp, int ph, LAS unsigned char* lds) {
    unsigned char* ws = pp->ws;
    float* HC = (float*)(ws + O_HC); bf16_t* A1 = (bf16_t*)(ws + O_A1); bf16_t* HID = (bf16_t*)(ws + O_U);
    bf16_t* Z = (bf16_t*)(ws + O_Z); bf16_t* ZT = (bf16_t*)(ws + O_ZT); bf16_t* ZTC = (bf16_t*)(ws + O_ZTC); bf16_t* AQ = (bf16_t*)(ws + O_AQ);
    bf16_t* Qb = (bf16_t*)(ws + O_Q); bf16_t* Kb = (bf16_t*)(ws + O_K); bf16_t* VT = (bf16_t*)(ws + O_VT);
    const float* mod = (const float*)(ws + O_MOD); float* PART = (float*)(ws + O_PART);
    if ((PHSEL & 1) && ph == 0) { phase0(tid, bid, G, pp, lds); return; }
    if (ph == NPH - 1) { final_norm(tid, bid, G, pp->out, pp->in[I_GFIN]); return; }
    const int layer = (ph - 1) / 12, loc = (ph - 1) % 12; const bool last = layer == 1;
    const unsigned char* wl = ws + O_W + (size_t)layer * W_LAYER; const float* modl = mod + (size_t)layer * 9 * NMOD;
    const int Mfull = MT, Mlate = last ? ML : MT;
    Sched S;
    switch (loc) {
    case 0: if (PHON(1)) norm_phase(tid, bid, G, layer == 0 ? pp->in[I_X] : pp->out, layer == 0 ? pp->in[I_CTX] : HC, Mfull, pp->in[I_GF1] + layer * D, modl, 0, 1, A1, layer == 0 ? nullptr : PART, HC); break;
    case 1: case 10: if (PHON(2)) { const int M = loc == 1 ? Mfull : Mlate; Gemm g{A1, (const bf16_t*)(wl + (loc == 1 ? W_13A : W_13B)), M, 2 * DFF, D}; S.init(M, 2 * DFF, G, bid); S.ntf = D / BK; EpiSwiglu E{HID}; gemm_phase(tid, lds, g, S, E); } break;
    case 2: case 11: case 8: if (PHON(3)) {
        const bool with_ctx = (loc == 2) || !last; const bool first = (loc == 2 && layer == 0);
        Gemm g; EpiResid E; E.hin_lat = first ? pp->in[I_X] : pp->out; E.hout_lat = pp->out; E.part = PART; Sched2 S2;
        if (loc == 8) { g = Gemm{A1, (const bf16_t*)(wl + W_OUT), MT, D, D}; E.gate = modl + 5 * D; E.scale = 1.f; S2.init(D, D, G, bid, with_ctx); }
        else { g = Gemm{HID, (const bf16_t*)(wl + (loc == 2 ? W_2A : W_2B)), MT, D, DFF}; E.gate = modl + (loc == 2 ? 2 : 8) * D; E.scale = 0.5f; S2.init(D, DFF, G, bid, with_ctx); }
        gemm_phase(tid, lds, g, S2, E);
        if (loc == 2 && layer == 0 && bid >= G / 2) { __syncthreads(); weight_transposes(pp, lds, 1, (bid - G / 2) * 8 + (tid >> 6), (G - G / 2) * 8, tid >> 6, tid & 63); } } break;
    case 3: if (PHON(1)) norm_phase(tid, bid, G, pp->out, HC, Mfull, pp->in[I_GMIX] + layer * D, modl, 3, 4, A1, PART, HC); break;
    case 4: if (PHON(4)) { Gemm g{A1, (const bf16_t*)(wl + W_IN), Mfull, NIN, D}; S.init(Mfull, NIN, G, bid); S.ntf = D / BK; EpiInproj E{Z, ZT, ZTC}; gemm_phase(tid, lds, g, S, E); } break;
    case 5: if (PHON(5)) {
        if (PHON(8)) prep_pool_phase(tid, bid, G, Z, AQ, Kb, A1, pp->in[I_GQ] + layer * 192, pp->in[I_GKV] + layer * 128, Mfull, Mlate);
        if (PHON(9)) sgu_phase(tid, bid, G, lds, Z, pp->in[I_GSGU] + layer * 256, (const bf16_t*)(wl + W_S), pp->in[I_BSGU] + layer * 512, A1, Mlate / 128);
        if (PHON(10)) fourier_pre(tid, bid, G, ZT, (bf16_t*)(ws + O_FE), (bf16_t*)(ws + O_FO), (float*)(ws + O_FX));
    } break;
    case 6: if (PHON(6)) {
        if (bid < 128) {
            const int sn = bid >> 6; int c2 = bid & 63; asm volatile("" : "+s"(c2));
            Gemm g{(const bf16_t*)(ws + O_DFT) + (size_t)sn * 2048 * 2048, (const bf16_t*)(ws + (sn ? O_FO : O_FE)), 2048, NB * 256, 2048}; S.init(2048, NB * 256, 64, c2); S.ntf = 2048 / BK;
            EpiF32 E{(float*)(ws + (sn ? O_SO : O_CE)), 2048}; gemm_phase(tid, lds, g, S, E);
        } else {
            int K2 = KQ, c2 = bid - 128; asm volatile("" : "+s"(K2), "+s"(c2));
            Gemm g{AQ, (const bf16_t*)(wl + W_QKV), Mfull, 1024, K2}; S.init(Mfull, 1024, G - 128, c2); S.ntf = K2 / BK; EpiQkv E{Qb, Kb, VT, 0.14724445f}; gemm_phase(tid, lds, g, S, E);
            if (!last) { __syncthreads(); int K3 = 512, c3 = bid - (G - 8); asm volatile("" : "+s"(K3), "+s"(c3)); Gemm g2{(const bf16_t*)(ws + O_DFTC), ZTC, CTX, NB * 256, K3}; S.init(CTX, NB * 256, 8, c3); S.ntf = K3 / BK; EpiFourier E2{A1, ML, CTX}; gemm_phase(tid, lds, g2, S, E2); }
        }
    } break;
    case 7: if (PHON(7)) { fourier_post(tid, bid, G, (const float*)(ws + O_CE), (const float*)(ws + O_SO), (const float*)(ws + O_FX), A1); attn_phase(tid, bid, G, lds, Qb, Kb, VT, A1, last ? 0 : 1); } break;
    case 9: if (PHON(1)) norm_phase(tid, bid, G, pp->out, HC, Mlate, pp->in[I_GF2] + layer * D, modl, 6, 7, A1, PART, HC); break;
    default: break;
    }
}

__global__ __launch_bounds__(512, 2) void mk_fwd(P p, int ph_lo, int ph_hi) {
    extern __shared__ __attribute__((aligned(16))) unsigned char shm[];
    LAS unsigned char* lds = (LAS unsigned char*)shm;
    cg::grid_group grid = cg::this_grid();
    const int wv = __builtin_amdgcn_readfirstlane((int)(threadIdx.x >> 6));
    volatile LAS unsigned* st = (volatile LAS unsigned*)(lds + LDS_BYTES - 16);
    unsigned xcc = 0; unsigned* bar = nullptr;
    if (ph_hi - ph_lo > 1) {
        CP* pp0 = (CP*)__builtin_amdgcn_kernarg_segment_ptr(); bar = (unsigned*)(pp0->ws + O_BAR); xcc = xb_xcc_id();
        if (threadIdx.x == 0) { st[0] = 0u; st[1] = 0u; (void)xb_add(&bar[XB_XCNT(xcc)], 1u); }
        __syncthreads();
    }
    for (int ph = ph_lo, rep = 0; ph < ph_hi;) {
        if (ph > ph_lo && rep == 0) { if (ph_hi < 0) grid.sync();
            else { int t0 = wv * 64 + (int)__builtin_amdgcn_mbcnt_hi(~0u, __builtin_amdgcn_mbcnt_lo(~0u, 0u)); xcd_barrier(bar, xcc, st, t0, gridDim.x); } }
        int wv2 = wv; asm volatile("" : "+s"(wv2));
        int tid = wv2 * 64 + (int)__builtin_amdgcn_mbcnt_hi(~0u, __builtin_amdgcn_mbcnt_lo(~0u, 0u)); asm volatile("" : "+v"(tid));
        int bid = blockIdx.x, G = gridDim.x; asm volatile("" : "+s"(bid), "+s"(G));
        CP* pp = (CP*)__builtin_amdgcn_kernarg_segment_ptr(); asm volatile("" : "+s"(pp));
        run_phase(tid, bid, G, pp, ph, lds);
        __syncthreads();
#if REPMASK
        { const int pt = ph == 0 ? 0 : (ph == NPH - 1 ? 13 : 1 + (ph - 1) % 12); const int nrep = ((REPMASK >> pt) & 1) ? REPN : 0;
          if (rep < nrep) ++rep; else { rep = 0; ++ph; } }
#else
        ++ph;
#endif
    }
}

extern "C" void kernel_launch(void* const* d_in, const int* in_sizes, int n_in, void* d_out, int out_size, void* d_ws, size_t ws_size, hipStream_t stream) {
    static int grid = 0;
    if (grid == 0) {
        if (n_in != 26 || out_size != ML * D || ws_size < WS_END) { fprintf(stderr, "kernel_launch: unexpected shapes (n_in %d out %d ws %zu need %zu)\n", n_in, out_size, ws_size, (size_t)WS_END); grid = -1; return; }
        int dev = 0, cus = 0, per_cu = 0;
        hipGetDevice(&dev); hipDeviceGetAttribute(&cus, hipDeviceAttributeMultiprocessorCount, dev);
        if (hipFuncSetAttribute((const void*)mk_fwd, hipFuncAttributeMaxDynamicSharedMemorySize, LDS_BYTES) != hipSuccess) { fprintf(stderr, "kernel_launch: hipFuncSetAttribute failed\n"); grid = -1; return; }
        if (hipOccupancyMaxActiveBlocksPerMultiprocessor(&per_cu, (const void*)mk_fwd, 512, LDS_BYTES) != hipSuccess || per_cu < 1) { fprintf(stderr, "kernel_launch: occupancy query says %d\n", per_cu); per_cu = 1; }
        (void)hipGetLastError();
        grid = cus * 1;
    }
    if (grid < 0) return;
    if (ONE_LAUNCH) (void)hipMemsetAsync((unsigned char*)d_ws + O_BAR, 0, 16384, stream);
    P p{};
    for (int i = 0; i < 26; ++i) p.in[i] = (const float*)d_in[i];
    p.out = (float*)d_out; p.ws = (unsigned char*)d_ws;
#if ONE_LAUNCH
    int lo = 0, hi = NPH; void* args[] = {&p, &lo, &hi};
    hipError_t e = hipLaunchCooperativeKernel((const void*)mk_fwd, dim3(grid), dim3(512), args, LDS_BYTES, stream);
    if (e != hipSuccess) fprintf(stderr, "cooperative launch failed: %s (grid %d)\n", hipGetErrorString(e), grid);
#else
    for (int ph = 0; ph < NPH; ++ph) hipLaunchKernelGGL(mk_fwd, dim3(grid), dim3(512), LDS_BYTES, stream, p, ph, ph + 1);
#endif
}
```

```cpp
#include <hip/hip_runtime.h>
#include <hip/hip_cooperative_groups.h>
#include <cstdio>
namespace cg = cooperative_groups;

#ifndef REPMASK
#define REPMASK 0
#endif
#ifndef REPN
#define REPN 1
#endif
#ifndef ONE_LAUNCH
#define ONE_LAUNCH 1
#endif

#define LAS __attribute__((address_space(3)))
typedef unsigned short bf16_t;
typedef short bf16x8 __attribute__((ext_vector_type(8)));
typedef float f32x4 __attribute__((ext_vector_type(4)));
typedef float f32x2 __attribute__((ext_vector_type(2)));
typedef unsigned u32x2 __attribute__((ext_vector_type(2)));
typedef unsigned u32x4 __attribute__((ext_vector_type(4)));

constexpr int D = 1024, NB = 8, SEQ = 4096, CTX = 256, ML = NB * SEQ, MC = NB * CTX, MT = ML + MC, DFF = 2816;
constexpr int ZW = 1120;
constexpr int NIN = 1792;
constexpr int KQ = 384;
constexpr int NKEY = SEQ + CTX;
constexpr int NMOD = 9 * D;
constexpr int LDS_BYTES = 147456;
constexpr int NPH = 26;

constexpr size_t O_HC = 0;
constexpr size_t O_A1 = O_HC + (size_t)MC * D * 4;
constexpr size_t O_U = O_A1 + (size_t)MT * D * 2;
constexpr size_t O_Z = O_U;
constexpr size_t O_ZT = O_Z + (size_t)MT * ZW * 2;
constexpr size_t O_ZTC = O_ZT + (size_t)NB * 256 * 8192 * 2;
constexpr size_t O_AQ = O_ZTC + (size_t)NB * 256 * 512 * 2;
constexpr size_t O_Q = O_AQ + (size_t)MT * KQ * 2;
constexpr size_t O_K = O_Q + (size_t)NB * 4 * NKEY * 96 * 2;
constexpr size_t O_VT = O_K + (size_t)NB * 4 * NKEY * 96 * 2;
constexpr size_t O_FE = O_VT + (size_t)NB * 4 * 64 * NKEY * 2;
constexpr size_t O_FO = O_FE + (size_t)NB * 256 * 2048 * 2;
constexpr size_t O_CE = O_FO + (size_t)NB * 256 * 2048 * 2;
constexpr size_t O_SO = O_CE + (size_t)NB * 2048 * 256 * 4;
constexpr size_t O_FX = O_SO + (size_t)NB * 2048 * 256 * 4;
constexpr size_t O_UEND = O_FX + (size_t)NB * 256 * 2 * 4;
constexpr size_t SZ_HID = (size_t)MT * DFF * 2;
constexpr size_t O_W = O_U + (O_UEND - O_U > SZ_HID ? O_UEND - O_U : SZ_HID);
constexpr size_t W_13A = 0;
constexpr size_t W_2A = W_13A + (size_t)2 * DFF * D * 2;
constexpr size_t W_IN = W_2A + (size_t)D * DFF * 2;
constexpr size_t W_QKV = W_IN + (size_t)NIN * D * 2;
constexpr size_t W_OUT = W_QKV + (size_t)1024 * KQ * 2;
constexpr size_t W_13B = W_OUT + (size_t)D * D * 2;
constexpr size_t W_2B = W_13B + (size_t)2 * DFF * D * 2;
constexpr size_t W_S = W_2B + (size_t)D * DFF * 2;
constexpr size_t W_LAYER = W_S + (size_t)4 * 128 * 128 * 2;
constexpr size_t O_DFT = O_W + 2 * W_LAYER;
constexpr size_t O_DFTC = O_DFT + (size_t)2 * 2048 * 2048 * 2;
constexpr size_t O_MOD = O_DFTC + (size_t)256 * 512 * 2;
constexpr size_t O_BAR = O_MOD + (size_t)2 * 9 * NMOD * 4;
constexpr size_t O_PART = O_BAR + 16384;
constexpr size_t WS_END = O_PART + (size_t)4 * MC * D * 4;

struct P { const float* in[26]; float* out; unsigned char* ws; };
typedef const P __attribute__((address_space(4))) CP;
enum { I_X = 0, I_C, I_CTX, I_CCTX, I_WADA, I_BADA, I_GF1, I_W13A, I_W2A, I_GMIX, I_WIN, I_WF, I_GQ, I_WUQ, I_GKV, I_WUKV, I_GSGU, I_WSGU, I_BSGU, I_WP, I_SP, I_WOUT, I_GF2, I_W13B, I_W2B, I_GFIN };

__device__ __forceinline__ unsigned pk2(float lo, float hi) { unsigned r; asm volatile("v_cvt_pk_bf16_f32 %0, %1, %2" : "=v"(r) : "v"(lo), "v"(hi)); return r; }
__device__ __forceinline__ bf16_t f2bf(float f) { return (bf16_t)(pk2(f, 0.f) & 0xffffu); }
__device__ __forceinline__ float bf2f(unsigned b) { return __uint_as_float(b << 16); }
__device__ __forceinline__ float wave_sum(float v) {
#pragma unroll
    for (int o = 1; o < 64; o <<= 1) v += __shfl_xor(v, o);
    return v;
}
__device__ __forceinline__ float silu_f(float a) { return a * __builtin_amdgcn_rcpf(1.f + __expf(-a)); }
__device__ __forceinline__ float gelu_f(float x) { const float y = 0.7978845608028654f * (x + 0.044715f * x * x * x); return x * __builtin_amdgcn_rcpf(1.f + __expf(-2.f * y)); }
__device__ __forceinline__ float dpp_xor1(float v) { return __int_as_float(__builtin_amdgcn_update_dpp(0, __float_as_int(v), 0xB1, 0xF, 0xF, true)); }
__device__ __forceinline__ float dpp_xor2(float v) { return __int_as_float(__builtin_amdgcn_update_dpp(0, __float_as_int(v), 0x4E, 0xF, 0xF, true)); }
__device__ __forceinline__ f32x4 quad_transpose(const f32x4 x, const int qi) {
    const bool h2 = qi & 2, h1 = qi & 1;
    const float r0 = dpp_xor2(h2 ? x[0] : x[2]), r1 = dpp_xor2(h2 ? x[1] : x[3]);
    const float z0 = h2 ? r0 : x[0], z1 = h2 ? r1 : x[1], z2 = h2 ? x[2] : r0, z3 = h2 ? x[3] : r1;
    const float own0 = h1 ? z1 : z0, own1 = h1 ? z3 : z2, q0 = dpp_xor1(h1 ? z0 : z1), q1 = dpp_xor1(h1 ? z2 : z3);
    f32x4 y; y[0] = h1 ? q0 : own0; y[1] = h1 ? own0 : q0; y[2] = h1 ? q1 : own1; y[3] = h1 ? own1 : q1; return y;
}
#define LDS_WAIT() asm volatile("s_waitcnt lgkmcnt(0)" ::: "memory")


#define XB_TMO      128
#define XB_XCNT(j)  (256  + 64 * (j))
#define XB_XSUB(j)  (1280 + 64 * (j))
#define XB_XGEN(j)  (2304 + 64 * (j))
#define XB_TOP      3328
#define XB_TOPGEN   3392
#define XCD_BAR_WORDS 3456
#define XB_SPIN_CAP (1u << 18)
__device__ __forceinline__ unsigned xb_ld(unsigned* p)              { return __hip_atomic_load(p, __ATOMIC_RELAXED, __HIP_MEMORY_SCOPE_AGENT); }
__device__ __forceinline__ unsigned xb_add(unsigned* p, unsigned v) { return __hip_atomic_fetch_add(p, v, __ATOMIC_RELAXED, __HIP_MEMORY_SCOPE_AGENT); }
__device__ __forceinline__ unsigned xb_xcc_id() { return (unsigned)__builtin_amdgcn_s_getreg((3 << 11) | 20) & 0xFu; }
#define XB_SPIN(cond, bar) do { unsigned _sp = 0; while (cond) { __builtin_amdgcn_s_sleep(1); \
    if ((++_sp & 255u) == 0u) { if (xb_ld(&(bar)[XB_TMO])) break; if (_sp > XB_SPIN_CAP) { atomicAdd(&(bar)[XB_TMO], 1u); break; } } } } while (0)
__device__ __forceinline__ void xcd_barrier_complete(unsigned* bar, unsigned x, unsigned G, unsigned& nloc, unsigned& nx) {
    unsigned sum, cnt, mine, sp = 0u;
    for (;;) {
        sum = 0u; cnt = 0u; mine = 0u;
#pragma unroll
        for (unsigned j = 0; j < 16; ++j) { const unsigned c = xb_ld(&bar[XB_XCNT(j)]); sum += c; cnt += (c > 0u) ? 1u : 0u; mine = (j == x) ? c : mine; }
        if (sum == G) break;
        __builtin_amdgcn_s_sleep(1);
        if ((++sp & 255u) == 0u) { if (xb_ld(&bar[XB_TMO])) break; if (sp > XB_SPIN_CAP) { atomicAdd(&bar[XB_TMO], 1u); break; } }
    }
    nloc = mine > 0u ? mine : 1u; nx = cnt > 0u ? cnt : 1u;
}
__device__ __forceinline__ void xcd_barrier(unsigned* bar, const unsigned x, volatile LAS unsigned* st, const int tid, const unsigned G) {
    asm volatile("s_waitcnt vmcnt(0)" ::: "memory");
    __syncthreads();
    if (tid == 0) {
        __builtin_amdgcn_s_waitcnt(0);
        unsigned nloc = st[0], nx = st[1];
        if (nloc == 0u) { xcd_barrier_complete(bar, x, G, nloc, nx); st[0] = nloc; st[1] = nx; }
        const unsigned old = xb_add(&bar[XB_XSUB(x)], 1u);
        const unsigned gen = old / nloc;
        if (old + 1u == (gen + 1u) * nloc) {
            __builtin_amdgcn_fence(__ATOMIC_RELEASE, "agent");
            asm volatile("s_waitcnt vmcnt(0)" ::: "memory");
            const unsigned og = xb_add(&bar[XB_TOP], 1u);
            const unsigned tg = og / nx;
            if (og + 1u == (tg + 1u) * nx) xb_add(&bar[XB_TOPGEN], 1u);
            else XB_SPIN(xb_ld(&bar[XB_TOPGEN]) == tg, bar);
            __builtin_amdgcn_fence(__ATOMIC_ACQUIRE, "agent");
            xb_add(&bar[XB_XGEN(x)], 1u);
            asm volatile("s_waitcnt vmcnt(0)" ::: "memory");
        } else {
            XB_SPIN(xb_ld(&bar[XB_XGEN(x)]) == gen, bar);
            __builtin_amdgcn_fence(__ATOMIC_ACQUIRE, "agent");
            asm volatile("s_waitcnt vmcnt(0)" ::: "memory");
        }
    }
    __syncthreads();
}

constexpr int BM = 256, BK = 64, HALF = 128, HTB = HALF * BK * 2, NXCD = 8, WGM = 4;
__device__ __forceinline__ int lds_byte(int r, int c) { const int st = (r >> 4) * 2 + (c >> 5), rr = r & 15, cc = c & 31, ob = rr * 64 + cc * 2; return st * 1024 + (ob ^ (((ob >> 9) & 1) << 5)); }
__device__ __forceinline__ void stage_rc(int b, int& R, int& C) { const int st = b / 1024, sb = b % 1024, swz = sb ^ (((sb >> 9) & 1) << 5); R = (st >> 1) * 16 + swz / 64; C = (st & 1) * 32 + (swz % 64) / 2; }
struct Unit { int pm, pn, koff, nt, ks; };
struct Gemm { const bf16_t* A; const bf16_t* Bt; int M, N, K; };
struct Sched {
    int nM, nN, nwg, G, c, ntf;
    __device__ __forceinline__ void init(int M, int N, int G_, int c_) { nM = M / BM; nN = N / BM; nwg = nM * nN; G = G_; c = c_; ntf = 0; }
    __device__ __forceinline__ bool next(int i, Unit& u) const {
        const int L = i * G + c; const bool ok = (c >= 0) && (L < nwg);
        int wgid = ok ? L : 0; { const int q = nwg / NXCD, r = nwg % NXCD, xcd = wgid % NXCD, off = wgid / NXCD; wgid = (xcd < r ? xcd * (q + 1) : r * (q + 1) + (xcd - r) * q) + off; }
        const int nig = WGM * nN, gid = wgid / nig, fm = gid * WGM, gsz = (nM - fm) < WGM ? (nM - fm) : WGM;
        u.pm = fm + ((wgid % nig) % gsz); u.pn = (wgid % nig) / gsz; u.koff = 0; u.nt = ntf; u.ks = -1; return ok;
    }
};
struct Sched2 {
    int nM, nN, nwg, G, c, ntf, nCu, K;
    __device__ __forceinline__ void init(int N, int K_, int G_, int c_, bool with_ctx) { nM = ML / BM; nN = N / BM; nwg = nM * nN; G = G_; c = c_; ntf = K_ / BK; nCu = with_ctx ? (MC / BM) * nN * 4 : 0; K = K_; }
    __device__ __forceinline__ bool next(int i, Unit& u) const {
        const int L = i * G + c; const bool lat = L < nwg; const bool ok = (c >= 0) && (L < nwg + nCu);
        int wgid = lat ? L : 0; { const int q = nwg / NXCD, r = nwg % NXCD, xcd = wgid % NXCD, off = wgid / NXCD; wgid = (xcd < r ? xcd * (q + 1) : r * (q + 1) + (xcd - r) * q) + off; }
        const int nig = WGM * nN, gid = wgid / nig, fm = gid * WGM, gsz = (nM - fm) < WGM ? (nM - fm) : WGM;
        const int lpm = fm + ((wgid % nig) % gsz), lpn = (wgid % nig) / gsz;
        const int s = ok && !lat ? L - nwg : 0, t = s >> 2, ks = s & 3, base = (ntf >> 3) * 2, rem = (ntf - 4 * base) >> 1;
        u.pm = lat ? lpm : nM + t / nN; u.pn = lat ? lpn : t % nN; u.koff = lat ? 0 : BK * (ks * base + 2 * (ks < rem ? ks : rem)); u.nt = lat ? ntf : base + (ks < rem ? 2 : 0); u.ks = lat ? -1 : ks; return ok;
    }
};
template <class Epi, class SchedT>
__device__ __forceinline__ void gemm_phase(const int tid, LAS unsigned char* lds, const Gemm g, const SchedT& S, const Epi& E) {
    const int wid = __builtin_amdgcn_readfirstlane(tid >> 6), lane = tid & 63, wr = wid >> 2, wc = wid & 3, fr = lane & 15, fq = lane >> 4;
    const int K = g.K;
    unsigned voffA[2];
#pragma unroll
    for (int i = 0; i < 2; ++i) { int R, C; stage_rc(tid * 16 + i * 8192, R, C); voffA[i] = (unsigned)(R * K + C) * 2u; }
    const size_t kstep = (size_t)(BK * 2);
    const size_t hstep = (size_t)HALF * K * 2;
    const size_t tstep = 2 * hstep;
    const unsigned ldsw = (unsigned)wid * 1024u;
    const int aoff = lds_byte(wr * 64 + fr, fq * 8), boff = lds_byte(wc * 32 + fr, fq * 8);
#define PG8_SA(b, h) (((b) * 2 + (h)) * HTB)
#define PG8_SB(b, h) ((4 + (b) * 2 + (h)) * HTB)
#define PG8_STAGE(bufoff, gbase) do { _Pragma("unroll") for (int _i = 0; _i < 2; ++_i) \
        __builtin_amdgcn_global_load_lds((const unsigned*)((const char*)(gbase) + voffA[_i]), (LAS unsigned*)(lds + (bufoff) + ldsw + _i * 8192), 16, 0, 0); } while (0)
#define PG8_LDA(dst, b, h) do { _Pragma("unroll") for (int m = 0; m < 4; ++m) _Pragma("unroll") for (int k = 0; k < 2; ++k) dst[m][k] = *(const LAS bf16x8*)(lds + PG8_SA(b, h) + aoff + m * 2048 + k * 1024); } while (0)
#define PG8_LDB(dst, b, h) do { _Pragma("unroll") for (int n = 0; n < 2; ++n) _Pragma("unroll") for (int k = 0; k < 2; ++k) dst[n][k] = *(const LAS bf16x8*)(lds + PG8_SB(b, h) + boff + n * 2048 + k * 1024); } while (0)
#define PG8_MMA(ai, bj, At, Bt) do { __builtin_amdgcn_s_setprio(1); _Pragma("unroll") for (int m = 0; m < 4; ++m) _Pragma("unroll") for (int n = 0; n < 2; ++n) _Pragma("unroll") for (int k = 0; k < 2; ++k) \
        acc[ai][bj][m][n] = __builtin_amdgcn_mfma_f32_16x16x32_bf16(Bt[n][k], At[m][k], acc[ai][bj][m][n], 0, 0, 0); __builtin_amdgcn_s_setprio(0); } while (0)
#define PG8_WAIT_V(n) asm volatile("s_waitcnt vmcnt(" #n ")" ::: "memory")
#define PG8_WAIT_L(n) asm volatile("s_waitcnt lgkmcnt(" #n ")" ::: "memory")
#define PG8_BAR __builtin_amdgcn_s_barrier()
#define PG8_SCHED __builtin_amdgcn_sched_barrier(0)
    Unit cur, nxt; int ui = 0;
    if (!S.next(0, cur)) return;
    f32x4 acc[2][2][4][2];
#pragma unroll
    for (int a = 0; a < 2; ++a)
#pragma unroll
        for (int b = 0; b < 2; ++b)
#pragma unroll
            for (int m = 0; m < 4; ++m)
#pragma unroll
                for (int n = 0; n < 2; ++n) acc[a][b][m][n] = (f32x4){0.f, 0.f, 0.f, 0.f};
    bf16x8 At[4][2], B0[2][2], B1[2][2];
    const char* cA = (const char*)g.A + (size_t)cur.pm * tstep + (size_t)cur.koff * 2; const char* cB = (const char*)g.Bt + (size_t)cur.pn * tstep + (size_t)cur.koff * 2;
    int nt = cur.nt;
    PG8_STAGE(PG8_SB(0, 0), cB); PG8_STAGE(PG8_SA(0, 0), cA); PG8_STAGE(PG8_SB(0, 1), cB + hstep); PG8_STAGE(PG8_SA(0, 1), cA + hstep);
    if (wr == 1) PG8_BAR;
    PG8_WAIT_V(4); PG8_BAR;
    PG8_STAGE(PG8_SB(1, 0), cB + kstep); PG8_STAGE(PG8_SA(1, 0), cA + kstep); PG8_STAGE(PG8_SB(1, 1), cB + hstep + kstep);
    PG8_WAIT_V(6); PG8_BAR;
    for (;;) {
        const bool has_next = S.next(ui + 1, nxt);
        const char* nA = has_next ? (const char*)g.A + (size_t)nxt.pm * tstep + (size_t)nxt.koff * 2 : cA; const char* nB = has_next ? (const char*)g.Bt + (size_t)nxt.pn * tstep + (size_t)nxt.koff * 2 : cB;
        for (int t = 0; t < nt; t += 2) {
            const bool last = (t == nt - 2);
            const char* a1 = cA + (size_t)(t + 1) * kstep;
            const char* a2 = last ? nA : cA + (size_t)(t + 2) * kstep; const char* b2 = last ? nB : cB + (size_t)(t + 2) * kstep;
            const char* a3 = a2 + kstep; const char* b3 = b2 + kstep;
            PG8_LDB(B0, 0, 0); PG8_SCHED; PG8_LDA(At, 0, 0); PG8_STAGE(PG8_SA(1, 1), a1 + hstep);
            PG8_WAIT_L(8); PG8_BAR; PG8_WAIT_L(0); PG8_MMA(0, 0, At, B0); PG8_BAR; PG8_SCHED;
            PG8_LDB(B1, 0, 1); PG8_STAGE(PG8_SB(0, 0), b2);
            PG8_BAR; PG8_WAIT_L(0); PG8_MMA(0, 1, At, B1); PG8_BAR;
            PG8_LDA(At, 0, 1); PG8_STAGE(PG8_SA(0, 0), a2);
            PG8_BAR; PG8_WAIT_L(0); PG8_MMA(1, 0, At, B0); PG8_BAR; PG8_SCHED;
            PG8_STAGE(PG8_SB(0, 1), b2 + hstep);
            PG8_WAIT_V(6); PG8_BAR; PG8_MMA(1, 1, At, B1); PG8_BAR;
            PG8_LDB(B0, 1, 0); PG8_SCHED; PG8_LDA(At, 1, 0); PG8_STAGE(PG8_SA(0, 1), a2 + hstep);
            PG8_WAIT_L(8); PG8_BAR; PG8_WAIT_L(0); PG8_MMA(0, 0, At, B0); PG8_BAR; PG8_SCHED;
            PG8_LDB(B1, 1, 1); PG8_STAGE(PG8_SB(1, 0), b3);
            PG8_BAR; PG8_WAIT_L(0); PG8_MMA(0, 1, At, B1); PG8_BAR;
            PG8_LDA(At, 1, 1); PG8_STAGE(PG8_SA(1, 0), a3);
            PG8_BAR; PG8_WAIT_L(0); PG8_MMA(1, 0, At, B0); PG8_BAR; PG8_SCHED;
            PG8_STAGE(PG8_SB(1, 1), b3 + hstep);
            PG8_WAIT_V(6); PG8_BAR; PG8_MMA(1, 1, At, B1); PG8_BAR;
        }
        E(acc, cur, wr, wc, fr, fq);
        if (!has_next) break;
#pragma unroll
        for (int a = 0; a < 2; ++a)
#pragma unroll
            for (int b = 0; b < 2; ++b)
#pragma unroll
                for (int m = 0; m < 4; ++m)
#pragma unroll
                    for (int n = 0; n < 2; ++n) acc[a][b][m][n] = (f32x4){0.f, 0.f, 0.f, 0.f};
        cur = nxt; cA = nA; cB = nB; nt = cur.nt; ++ui;
    }
    PG8_WAIT_V(0);
    if (wr == 0) PG8_BAR;
    PG8_BAR;
}

struct EpiSwiglu {
    bf16_t* hid;
    __device__ __forceinline__ void operator()(const f32x4 (&acc)[2][2][4][2], const Unit& u, int wr, int wc, int fr, int fq) const {
        const int row0 = u.pm * BM + wr * 64 + fr, col0 = u.pn * 128 + wc * 32 + 8 * fq;
#pragma unroll
        for (int ai = 0; ai < 2; ++ai)
#pragma unroll
            for (int m = 0; m < 4; ++m) { bf16_t* rowp = hid + (size_t)(row0 + ai * HALF + m * 16) * DFF + col0;
                const f32x4 a0 = acc[ai][0][m][0], b0 = acc[ai][1][m][0], a1 = acc[ai][0][m][1], b1 = acc[ai][1][m][1];
                u32x4 o; o.x = pk2(silu_f(a0[0]) * b0[0], silu_f(a0[1]) * b0[1]); o.y = pk2(silu_f(a0[2]) * b0[2], silu_f(a0[3]) * b0[3]);
                o.z = pk2(silu_f(a1[0]) * b1[0], silu_f(a1[1]) * b1[1]); o.w = pk2(silu_f(a1[2]) * b1[2], silu_f(a1[3]) * b1[3]);
                *(u32x4*)rowp = o; }
    }
};
struct EpiResid {
    const float* hin_lat; float* hout_lat; float* part; const float* gate; float scale;
    __device__ __forceinline__ void operator()(const f32x4 (&acc)[2][2][4][2], const Unit& u, int wr, int wc, int fr, int fq) const {
        const int r0 = u.pm * BM; const bool isctx = r0 >= ML; const int bidx = isctx ? 8 : (r0 >> 12);
        const float* gr = gate + (size_t)bidx * NMOD;
        const int col0 = u.pn * BM + wc * 32 + 4 * fq;
        f32x4 gv[2][2];
#pragma unroll
        for (int bj = 0; bj < 2; ++bj)
#pragma unroll
            for (int n = 0; n < 2; ++n) gv[bj][n] = *(const f32x4*)(gr + col0 + bj * HALF + n * 16) * scale;
        const size_t rowoff = (size_t)(wr * 64 + fr) * D + col0;
        if (isctx) {
            float* ho = part + ((size_t)(u.ks & 3) * MC + (r0 - ML)) * D + rowoff;
#pragma unroll
            for (int ai = 0; ai < 2; ++ai)
#pragma unroll
                for (int m = 0; m < 4; ++m)
#pragma unroll
                    for (int bj = 0; bj < 2; ++bj)
#pragma unroll
                        for (int n = 0; n < 2; ++n) *(f32x4*)(ho + (size_t)(ai * HALF + m * 16) * D + bj * HALF + n * 16) = gv[bj][n] * acc[ai][bj][m][n];
        } else {
            const float* hi = hin_lat + (size_t)r0 * D + rowoff; float* ho = hout_lat + (size_t)r0 * D + rowoff;
#pragma unroll
            for (int ai = 0; ai < 2; ++ai) {
                f32x4 hv[4][2][2];
#pragma unroll
                for (int m = 0; m < 4; ++m)
#pragma unroll
                    for (int bj = 0; bj < 2; ++bj)
#pragma unroll
                        for (int n = 0; n < 2; ++n) hv[m][bj][n] = *(const f32x4*)(hi + (size_t)(ai * HALF + m * 16) * D + bj * HALF + n * 16);
#pragma unroll
                for (int m = 0; m < 4; ++m)
#pragma unroll
                    for (int bj = 0; bj < 2; ++bj)
#pragma unroll
                        for (int n = 0; n < 2; ++n) *(f32x4*)(ho + (size_t)(ai * HALF + m * 16) * D + bj * HALF + n * 16) = hv[m][bj][n] + gv[bj][n] * acc[ai][bj][m][n];
            }
        }
    }
};
struct EpiInproj {
    bf16_t* Z; bf16_t* Zt; bf16_t* Ztc;
    __device__ __forceinline__ void operator()(const f32x4 (&acc)[2][2][4][2], const Unit& u, int wr, int wc, int fr, int fq) const {
        const int r0 = u.pm * BM; const bool isctx = r0 >= ML;
        if (u.pn < 2) {
            const int part = u.pn, qi = fr & 3;
#pragma unroll
            for (int ai = 0; ai < 2; ++ai)
#pragma unroll
                for (int m = 0; m < 4; ++m) { const int r = r0 + ai * HALF + wr * 64 + m * 16 + fr - qi;
                    bf16_t* base; size_t stride;
                    if (!isctx) { const int b = r >> 12, l = r & 4095; base = Zt + (size_t)b * 256 * 8192 + part * 4096 + l; stride = 8192; }
                    else { const int rc = r - ML, b = rc >> 8, l = rc & 255; base = Ztc + (size_t)b * 256 * 512 + part * 256 + l; stride = 512; }
#pragma unroll
                    for (int bj = 0; bj < 2; ++bj)
#pragma unroll
                        for (int n = 0; n < 2; ++n) { const int hd = bj * HALF + wc * 32 + n * 16 + 4 * fq + qi;
                            const f32x4 y = quad_transpose(acc[ai][bj][m][n], qi);
                            u32x2 o; o.x = pk2(y[0], y[1]); o.y = pk2(y[2], y[3]); *(u32x2*)(base + (size_t)hd * stride) = o; } }
        } else {
            const int colt = (u.pn - 2) * BM + wc * 32 + 4 * fq;
#pragma unroll
            for (int ai = 0; ai < 2; ++ai)
#pragma unroll
                for (int m = 0; m < 4; ++m) { const int r = r0 + ai * HALF + wr * 64 + m * 16 + fr; bf16_t* rowp = Z + (size_t)r * ZW;
#pragma unroll
                    for (int bj = 0; bj < 2; ++bj)
#pragma unroll
                        for (int n = 0; n < 2; ++n) { const int col = colt + bj * HALF + n * 16;
                            if (col < ZW) { const f32x4 v = acc[ai][bj][m][n]; u32x2 o; o.x = pk2(v[0], v[1]); o.y = pk2(v[2], v[3]); *(u32x2*)(rowp + col) = o; } } }
        }
    }
};
struct EpiQkv {
    bf16_t* Q; bf16_t* Kb; bf16_t* Vt; float qscale;
    __device__ __forceinline__ void operator()(const f32x4 (&acc)[2][2][4][2], const Unit& u, int wr, int wc, int fr, int fq) const {
        const int r0 = u.pm * BM; const bool isctx = r0 >= ML;
        if (u.pn < 2 && wc == 3) return;
#pragma unroll
        for (int ai = 0; ai < 2; ++ai)
#pragma unroll
            for (int m = 0; m < 4; ++m) {
                __builtin_amdgcn_sched_barrier(0);
                const int r = r0 + ai * HALF + wr * 64 + m * 16 + fr;
                int b, pos; if (!isctx) { b = r >> 12; pos = r & 4095; } else { const int rc = r - ML; b = rc >> 8; pos = SEQ + (rc & 255); }
#pragma unroll
                for (int bj = 0; bj < 2; ++bj) {
                    const int h = (u.pn & 1) * 2 + bj;
                    if (u.pn < 2 || wc < 2) {
                        bf16_t* qp = (u.pn < 2 ? Q : Kb) + ((size_t)(b * 4 + h) * NKEY + pos) * 96 + wc * 32 + 4 * fq; const float sc = u.pn < 2 ? qscale : 1.f;
#pragma unroll
                        for (int n = 0; n < 2; ++n) { const f32x4 v = acc[ai][bj][m][n] * sc; u32x2 o; o.x = pk2(v[0], v[1]); o.y = pk2(v[2], v[3]); *(u32x2*)(qp + n * 16) = o; }
                    } else {
                        bf16_t* vp = Vt + ((size_t)(b * 4 + h) * 64 + (wc - 2) * 32 + 4 * fq) * NKEY + pos;
#pragma unroll
                        for (int n = 0; n < 2; ++n)
#pragma unroll
                            for (int e = 0; e < 4; ++e) vp[(size_t)(n * 16 + e) * NKEY] = f2bf(acc[ai][bj][m][n][e]);
                    }
                }
            }
    }
};
struct EpiFourier {
    bf16_t* ymix; int rowbase0, rows_per_b;
    __device__ __forceinline__ void operator()(const f32x4 (&acc)[2][2][4][2], const Unit& u, int wr, int wc, int fr, int fq) const {
        const int b = u.pn;
#pragma unroll
        for (int ai = 0; ai < 2; ++ai)
#pragma unroll
            for (int m = 0; m < 4; ++m) { const int k = u.pm * BM + ai * HALF + wr * 64 + m * 16 + fr; bf16_t* rowp = ymix + (size_t)(rowbase0 + b * rows_per_b + k) * D + wc * 32 + 4 * fq;
#pragma unroll
                for (int bj = 0; bj < 2; ++bj)
#pragma unroll
                    for (int n = 0; n < 2; ++n) { const f32x4 v = acc[ai][bj][m][n]; u32x2 o; o.x = pk2(v[0], v[1]); o.y = pk2(v[2], v[3]); *(u32x2*)(rowp + bj * HALF + n * 16) = o; } }
    }
};

struct EpiF32 {
    float* C; int M;
    __device__ __forceinline__ void operator()(const f32x4 (&acc)[2][2][4][2], const Unit& u, int wr, int wc, int fr, int fq) const {
        float* base = C + ((size_t)u.pn * M + (size_t)u.pm * BM + wr * 64 + fr) * 256 + wc * 32 + 4 * fq;
#pragma unroll
        for (int ai = 0; ai < 2; ++ai)
#pragma unroll
            for (int m = 0; m < 4; ++m)
#pragma unroll
                for (int bj = 0; bj < 2; ++bj)
#pragma unroll
                    for (int n = 0; n < 2; ++n) *(f32x4*)(base + (size_t)(ai * HALF + m * 16) * 256 + bj * HALF + n * 16) = acc[ai][bj][m][n];
    }
};

__device__ __forceinline__ void fourier_pre(const int tid, const int bid, const int G, const bf16_t* __restrict__ ZT, bf16_t* __restrict__ FE, bf16_t* __restrict__ FO, float* __restrict__ FX) {
    const int lane = tid & 63, gw = bid * 8 + (tid >> 6), NGW = G * 8;
    for (int row = gw; row < NB * 256; row += NGW) {
        const bf16_t* zc = ZT + (size_t)row * 8192; const bf16_t* zs = zc + 4096; float alt = 0.f;
        u32x4 cv[4], sv[4], cA[4], sA[4]; unsigned cB[4], sB[4];
#pragma unroll
        for (int j = 0; j < 4; ++j) { const int l0 = 8 * (lane + 64 * j);
            cv[j] = *(const u32x4*)(zc + l0); sv[j] = *(const u32x4*)(zs + l0); cA[j] = *(const u32x4*)(zc + 4096 - l0 - 8); sA[j] = *(const u32x4*)(zs + 4096 - l0 - 8);
            cB[j] = *(const unsigned*)(zc + 4096 - l0); sB[j] = *(const unsigned*)(zs + 4096 - l0); }
        const float z2048 = bf2f(zc[2048]);
#pragma unroll
        for (int j = 0; j < 4; ++j) { const int l0 = 8 * (lane + 64 * j);
            const unsigned cw[4] = {cv[j].x, cv[j].y, cv[j].z, cv[j].w}, sw[4] = {sv[j].x, sv[j].y, sv[j].z, sv[j].w}, ca[4] = {cA[j].x, cA[j].y, cA[j].z, cA[j].w}, sa[4] = {sA[j].x, sA[j].y, sA[j].z, sA[j].w};
            float e8[8], o8[8];
#pragma unroll
            for (int e = 0; e < 8; ++e) { const float c = bf2f((e & 1) ? (cw[e >> 1] >> 16) : (cw[e >> 1] & 0xffffu)), s = bf2f((e & 1) ? (sw[e >> 1] >> 16) : (sw[e >> 1] & 0xffffu));
                float cm, sm;
                if (e == 0) { cm = bf2f(cB[j] & 0xffffu); sm = bf2f(sB[j] & 0xffffu); if (l0 == 0) { cm = 0.f; sm = s; } }
                else { const int m = 8 - e; cm = bf2f((m & 1) ? (ca[m >> 1] >> 16) : (ca[m >> 1] & 0xffffu)); sm = bf2f((m & 1) ? (sa[m >> 1] >> 16) : (sa[m >> 1] & 0xffffu)); }
                e8[e] = c + cm; o8[e] = s - sm; alt += (e & 1) ? -e8[e] : e8[e]; }
            u32x4 eo; eo.x = pk2(e8[0], e8[1]); eo.y = pk2(e8[2], e8[3]); eo.z = pk2(e8[4], e8[5]); eo.w = pk2(e8[6], e8[7]);
            u32x4 oo; oo.x = pk2(o8[0], o8[1]); oo.y = pk2(o8[2], o8[3]); oo.z = pk2(o8[4], o8[5]); oo.w = pk2(o8[6], o8[7]);
            *(u32x4*)(FE + (size_t)row * 2048 + l0) = eo; *(u32x4*)(FO + (size_t)row * 2048 + l0) = oo; }
        alt = wave_sum(alt) + z2048;
        if (lane == 0) { FX[row * 2] = alt; FX[row * 2 + 1] = z2048; }
    }
}
__device__ __forceinline__ void fourier_post(const int tid, const int bid, const int G, const float* __restrict__ CE, const float* __restrict__ SO, const float* __restrict__ FX, bf16_t* __restrict__ ymix) {
    const int gt = bid * 512 + tid, gs = G * 512;
    for (int it0 = gt; it0 < NB * 2048 * 64; it0 += 4 * gs) {
        f32x4 ce[4], so[4]; float fz[4][4], fr[4][4];
#pragma unroll
        for (int q = 0; q < 4; ++q) { const int it = it0 + q * gs; const int itc = it < NB * 2048 * 64 ? it : it0; const int hd = (itc & 63) * 4, k = (itc >> 6) & 2047, b = itc >> 17;
            ce[q] = *(const f32x4*)(CE + ((size_t)b * 2048 + k) * 256 + hd); so[q] = *(const f32x4*)(SO + ((size_t)b * 2048 + k) * 256 + hd);
#pragma unroll
            for (int e = 0; e < 4; ++e) { fz[q][e] = FX[(b * 256 + hd + e) * 2 + 1]; fr[q][e] = FX[(b * 256 + hd + e) * 2]; } }
#pragma unroll
        for (int q = 0; q < 4; ++q) { const int it = it0 + q * gs; if (it >= NB * 2048 * 64) break; const int hd = (it & 63) * 4, k = (it >> 6) & 2047, b = it >> 17;
            const float sg = (k & 1) ? (-1.f / 512.f) : (1.f / 512.f); f32x4 z2, r2;
#pragma unroll
            for (int e = 0; e < 4; ++e) { z2[e] = fz[q][e] * sg; r2[e] = fr[q][e] * (1.f / 512.f); }
            const f32x4 cz = ce[q] + z2, lo = cz - so[q], hi = cz + so[q];
            u32x2 o; o.x = pk2(lo[0], lo[1]); o.y = pk2(lo[2], lo[3]); *(u32x2*)(ymix + ((size_t)b * SEQ + k) * D + hd) = o;
            if (k) { o.x = pk2(hi[0], hi[1]); o.y = pk2(hi[2], hi[3]); *(u32x2*)(ymix + ((size_t)b * SEQ + SEQ - k) * D + hd) = o; }
            else { o.x = pk2(r2[0], r2[1]); o.y = pk2(r2[2], r2[3]); *(u32x2*)(ymix + ((size_t)b * SEQ + 2048) * D + hd) = o; }
        }
    }
}

__device__ __forceinline__ int rowmap13(int n) { const int s = n >= DFF; const int nn = n - s * DFF; const int r = (nn >> 7) * 256 + s * 128 + (nn & 127), c = r & 31;
    return (r & ~31) + ((c >> 2) & 1) * 16 + (c >> 3) * 4 + (c & 3); }
__device__ __forceinline__ void tr_item(const float* W, int N, int ncol0, int nblk, bf16_t* WT, int ldd, int mode, int row_off, LAS float* scr, int item, int lane) {
    const int kb = item / nblk, nb = item % nblk, k0 = 64 * kb, n0 = ncol0 + 32 * nb;
    float tv[32];
#pragma unroll
    for (int i = 0; i < 32; ++i) tv[i] = W[(size_t)(k0 + 2 * i + (lane >> 5)) * N + n0 + (lane & 31)];
#pragma unroll
    for (int i = 0; i < 32; ++i) scr[(2 * i + (lane >> 5)) * 33 + (lane & 31)] = tv[i];
    LDS_WAIT();
    const int c = lane & 7;
#pragma unroll
    for (int j = 0; j < 4; ++j) { const int n = (lane >> 3) + 8 * j; const LAS float* s = scr + (8 * c) * 33 + n;
        u32x4 o; o.x = pk2(s[0 * 33], s[1 * 33]); o.y = pk2(s[2 * 33], s[3 * 33]); o.z = pk2(s[4 * 33], s[5 * 33]); o.w = pk2(s[6 * 33], s[7 * 33]);
        const int drow = mode ? rowmap13(n0 + n) : row_off + (n0 - ncol0) + n;
        *(u32x4*)(WT + (size_t)drow * ldd + k0 + 8 * c) = o; }
    LDS_WAIT();
}
__device__ __forceinline__ void weight_transposes(CP* pp, LAS unsigned char* lds, const int layer, const int gw, const int NGW, const int wid, const int lane) {
    LAS float* scr = (LAS float*)(lds + wid * 8448);
    constexpr int I13 = 16 * 176, I2 = 44 * 32, IIN = 16 * 27, IOUT = 16 * 32, ILAY = 2 * I13 + 2 * I2 + IIN + IOUT;
    unsigned char* wl = pp->ws + O_W + (size_t)layer * W_LAYER;
    for (int it = gw; it < ILAY; it += NGW) {
        int r = it;
        if (r < I13) { tr_item(pp->in[I_W13A] + (size_t)layer * D * 2 * DFF, 2 * DFF, 0, 176, (bf16_t*)(wl + W_13A), D, 1, 0, scr, r, lane); continue; } r -= I13;
        if (r < I13) { tr_item(pp->in[I_W13B] + (size_t)layer * D * 2 * DFF, 2 * DFF, 0, 176, (bf16_t*)(wl + W_13B), D, 1, 0, scr, r, lane); continue; } r -= I13;
        if (r < I2) { tr_item(pp->in[I_W2A] + (size_t)layer * DFF * D, D, 0, 32, (bf16_t*)(wl + W_2A), DFF, 0, 0, scr, r, lane); continue; } r -= I2;
        if (r < I2) { tr_item(pp->in[I_W2B] + (size_t)layer * DFF * D, D, 0, 32, (bf16_t*)(wl + W_2B), DFF, 0, 0, scr, r, lane); continue; } r -= I2;
        if (r < IIN) { tr_item(pp->in[I_WIN] + (size_t)layer * D * 1376, 1376, 256, 27, (bf16_t*)(wl + W_IN), D, 0, 512, scr, r, lane); continue; } r -= IIN;
        tr_item(pp->in[I_WOUT] + (size_t)layer * D * D, D, 0, 32, (bf16_t*)(wl + W_OUT), D, 0, 0, scr, r, lane);
    }
}
__device__ __forceinline__ void phase0(const int tid, const int bid, const int G, CP* pp, LAS unsigned char* lds) {
    const int wid = tid >> 6, lane = tid & 63;
    unsigned char* ws = pp->ws;
    weight_transposes(pp, lds, 0, bid * 8 + wid, G * 8, wid, lane);
    __syncthreads();
    {
        const size_t gt = (size_t)bid * 512 + tid, gs = (size_t)G * 512;
        bf16_t* dft = (bf16_t*)(ws + O_DFT);
        for (size_t ch = gt; ch < (size_t)2 * 2048 * 256; ch += gs) {
            const int part = (int)(ch >> 19), k = (int)(ch >> 8) & 2047, l0 = (int)(ch & 255) * 8; float v[8];
#pragma unroll
            for (int e = 0; e < 8; ++e) { const float x = (float)((k * (l0 + e)) & 4095) * (1.f / 4096.f); v[e] = (part ? __builtin_amdgcn_sinf(x) : __builtin_amdgcn_cosf(x)) * (1.f / 512.f); }
            u32x4 o; o.x = pk2(v[0], v[1]); o.y = pk2(v[2], v[3]); o.z = pk2(v[4], v[5]); o.w = pk2(v[6], v[7]);
            *(u32x4*)(dft + (size_t)ch * 8) = o;
        }
        bf16_t* dftc = (bf16_t*)(ws + O_DFTC);
        for (size_t i = gt; i < (size_t)256 * 512; i += gs) { const int k = (int)(i >> 9), col = (int)(i & 511), part = col >> 8, l = col & 255;
            const float x = (float)((k * l) & 255) * (1.f / 256.f); dftc[i] = f2bf((part ? -__builtin_amdgcn_sinf(x) : __builtin_amdgcn_cosf(x)) * (1.f / 128.f)); }
        for (int layer = 0; layer < 2; ++layer) {
            unsigned char* wl = ws + O_W + (size_t)layer * W_LAYER;
            bf16_t* wq = (bf16_t*)(wl + W_QKV); const float* wuq = pp->in[I_WUQ] + (size_t)layer * 192 * 384; const float* wukv = pp->in[I_WUKV] + (size_t)layer * 128 * 512;
            for (size_t i = gt; i < (size_t)1024 * KQ; i += gs) { const int n = (int)(i / KQ), k = (int)(i % KQ); float val = 0.f;
                if (n < 512) { const int h = n >> 7, c = n & 127;
                    if (c < 96) { int sd = c; if (c >= 64) { const int c2 = c - 64, nn = c2 >> 4, ii = c2 & 15; sd = 64 + (ii >> 3) * 16 + nn * 8 + (ii & 7); } if (k < 192) val = wuq[(size_t)k * 384 + h * 96 + sd]; }
                } else { const int n2 = n - 512; if (k >= 192 && k < 320) val = wukv[(size_t)(k - 192) * 512 + n2]; }
                wq[i] = f2bf(val); }
            bf16_t* wsb = (bf16_t*)(wl + W_S); const float* wsg = pp->in[I_WSGU] + (size_t)layer * 4 * 128 * 128;
            for (size_t i = gt; i < (size_t)4 * 128 * 128; i += gs) wsb[i] = f2bf(wsg[i]);
        }
    }
    {
        LAS float* T = (LAS float*)(lds + 122880);
        LAS float* Wl = (LAS float*)(lds + 67584);
        LAS float* wfl = (LAS float*)(lds + 100352);
        LAS float* tab = (LAS float*)(lds + 116736);
        constexpr int NF = 2 * 2 * 4 * 8, NPL = 2 * 4 * 8;
        for (int it = bid; it < NF + NPL; it += G) {
            int layer, srccol, destrow, kch, part = 0; const bool four = it < NF;
            if (four) { layer = it >> 6; part = (it >> 5) & 1; const int h = (it >> 3) & 3; kch = it & 7; srccol = h * 64; destrow = part * 256 + h * 64; }
            else { const int r = it - NF; layer = r >> 5; const int g = (r >> 3) & 3; kch = r & 7; srccol = 1120 + g * 64; destrow = 512 + 864 + g * 64; }
            const float* win = pp->in[I_WIN] + (size_t)layer * D * 1376;
            __syncthreads();
            for (int i = tid; i < 2048; i += 512) { const int row = i >> 4, c4 = i & 15; *(LAS f32x4*)(Wl + row * 64 + c4 * 4) = *(const f32x4*)(win + (size_t)(kch * 128 + row) * 1376 + srccol + c4 * 4); }
            if (four) { const float* wf = pp->in[I_WF] + (size_t)(layer * 4 + (srccol >> 6)) * 4096;
                for (int i = tid; i < 1024; i += 512) *(LAS f32x4*)(wfl + i * 4) = *(const f32x4*)(wf + i * 4);
                if (tid < 64) { const float x = (float)tid * (1.f / 64.f); tab[tid] = part ? __builtin_amdgcn_sinf(x) : __builtin_amdgcn_cosf(x); }
                __syncthreads();
                for (int idx = tid; idx < 4096; idx += 512) { const int c = idx >> 6, d = idx & 63; float s = 0.f;
#pragma unroll 16
                    for (int j = 0; j < 64; ++j) s += tab[(j * c) & 63] * wfl[j * 64 + d];
                    T[idx] = s; }
            } else { const int g = (srccol - 1120) >> 6; const float* wp = pp->in[I_WP] + (size_t)(layer * 4 + g) * 4096; const float* sp = pp->in[I_SP] + layer * 256 + g * 64;
                for (int idx = tid; idx < 4096; idx += 512) T[idx] = wp[idx] * sp[idx & 63]; }
            __syncthreads();
            bf16_t* wint = (bf16_t*)(ws + O_W + (size_t)layer * W_LAYER + W_IN);
            const int d = tid & 63, ks = tid >> 6;
            float Tr[64];
#pragma unroll
            for (int c = 0; c < 64; ++c) Tr[c] = T[c * 64 + d];
            for (int i = 0; i < 16; ++i) { const int kk = ks + 8 * i; float s = 0.f;
#pragma unroll
                for (int c4 = 0; c4 < 16; ++c4) { const f32x4 w = *(const LAS f32x4*)(Wl + kk * 64 + c4 * 4); s += w[0] * Tr[4 * c4] + w[1] * Tr[4 * c4 + 1] + w[2] * Tr[4 * c4 + 2] + w[3] * Tr[4 * c4 + 3]; }
                wint[(size_t)(destrow + d) * D + kch * 128 + kk] = f2bf(s); }
        }
        __syncthreads();
    }
    {
        LAS float* sc = (LAS float*)(lds);
        LAS float* red = (LAS float*)(lds + 36864);
        for (int idx = tid; idx < 9 * D; idx += 512) { const int r = idx >> 10, k = idx & 1023; const float v = r < 8 ? pp->in[I_C][r * D + k] : pp->in[I_CCTX][k]; sc[idx] = v / (1.f + expf(-v)); }
        __syncthreads();
        float* mod = (float*)(ws + O_MOD);
        for (int it = bid; it < 2 * 144; it += G) {
            const int layer = it / 144, n0 = (it % 144) * 64, col = tid & 63, kg = tid >> 6;
            const float* wa = pp->in[I_WADA] + (size_t)layer * D * NMOD + n0 + col;
            float a[9];
#pragma unroll
            for (int r = 0; r < 9; ++r) a[r] = 0.f;
            for (int k0 = kg * 128; k0 < kg * 128 + 128; k0 += 16) { float w[16];
#pragma unroll
                for (int u = 0; u < 16; ++u) w[u] = wa[(size_t)(k0 + u) * NMOD];
#pragma unroll
                for (int r = 0; r < 9; ++r)
#pragma unroll
                    for (int u4 = 0; u4 < 4; ++u4) { const f32x4 s4 = *(const LAS f32x4*)(sc + r * D + k0 + 4 * u4); a[r] += s4[0] * w[4 * u4] + s4[1] * w[4 * u4 + 1] + s4[2] * w[4 * u4 + 2] + s4[3] * w[4 * u4 + 3]; } }
#pragma unroll
            for (int r = 0; r < 9; ++r) red[(kg * 9 + r) * 64 + col] = a[r];
            __syncthreads();
            for (int idx = tid; idx < 576; idx += 512) { const int r = idx >> 6, cc = idx & 63; float s = pp->in[I_BADA][layer * NMOD + n0 + cc];
#pragma unroll
                for (int g2 = 0; g2 < 8; ++g2) s += red[(g2 * 9 + r) * 64 + cc];
                mod[(size_t)(layer * 9 + r) * NMOD + n0 + cc] = s; }
            __syncthreads();
        }
    }
}

__device__ __forceinline__ void norm_phase(const int tid, const int bid, const int G, const float* src_lat, const float* src_ctx, int nrows, const float* g, const float* modl, int ishift, int iscale, bf16_t* dst, const float* part, float* hc_out) {
    const int lane = tid & 63, gw = bid * 8 + (tid >> 6), NGW = G * 8;
    f32x4 gg[4];
#pragma unroll
    for (int j = 0; j < 4; ++j) gg[j] = *(const f32x4*)(g + 4 * lane + 256 * j);
    for (int rb = gw; rb < nrows; rb += 2 * NGW) {
        f32x4 v[2][4]; f32x4 pa[2][4]; f32x4 scv[2][4], shv[2][4];
#pragma unroll
        for (int q = 0; q < 2; ++q) { const int r = rb + q * NGW; const bool on = r < nrows; const int rr = on ? r : rb;
            const float* src = rr < ML ? src_lat + (size_t)rr * D : src_ctx + (size_t)(rr - ML) * D; const bool fold = (rr >= ML) && (part != nullptr);
            const float* mr0 = modl + (size_t)(rr < ML ? (rr >> 12) : 8) * NMOD;
#pragma unroll
            for (int j = 0; j < 4; ++j) { v[q][j] = ((const f32x4*)src)[lane + 64 * j]; scv[q][j] = *(const f32x4*)(mr0 + iscale * D + 4 * lane + 256 * j); shv[q][j] = *(const f32x4*)(mr0 + ishift * D + 4 * lane + 256 * j);
                pa[q][j] = (f32x4){0.f, 0.f, 0.f, 0.f};
                if (fold) { const f32x4* pq = (const f32x4*)(part + (size_t)(rr - ML) * D) + lane + 64 * j; pa[q][j] = (pq[0] + pq[(size_t)MC * D / 4]) + (pq[(size_t)2 * MC * D / 4] + pq[(size_t)3 * MC * D / 4]); } } }
#pragma unroll
        for (int q = 0; q < 2; ++q) { const int r = rb + q * NGW; if (r >= nrows) break; float ss = 0.f;
#pragma unroll
            for (int j = 0; j < 4; ++j) { v[q][j] = v[q][j] + pa[q][j]; ss += v[q][j][0] * v[q][j][0] + v[q][j][1] * v[q][j][1] + v[q][j][2] * v[q][j][2] + v[q][j][3] * v[q][j][3]; }
            if (r >= ML) {
#pragma unroll
                for (int j = 0; j < 4; ++j) ((f32x4*)(hc_out + (size_t)(r - ML) * D))[lane + 64 * j] = v[q][j]; }
            const float rstd = rsqrtf(wave_sum(ss) * (1.f / D) + 1e-6f);
#pragma unroll
            for (int j = 0; j < 4; ++j) { const int c = 4 * lane + 256 * j;
                const f32x4 y = v[q][j] * rstd * gg[j] * (scv[q][j] + 1.f) + shv[q][j]; u32x2 o; o.x = pk2(y[0], y[1]); o.y = pk2(y[2], y[3]); *(u32x2*)(dst + (size_t)r * D + c) = o; }
        }
    }
}
__device__ __forceinline__ void final_norm(const int tid, const int bid, const int G, float* h, const float* g) {
    const int lane = tid & 63, gw = bid * 8 + (tid >> 6), NGW = G * 8;
    f32x4 gg[4];
#pragma unroll
    for (int j = 0; j < 4; ++j) gg[j] = *(const f32x4*)(g + 4 * lane + 256 * j);
    for (int rb = gw; rb < ML; rb += 2 * NGW) {
        f32x4 v[2][4];
#pragma unroll
        for (int q = 0; q < 2; ++q) { const int r = rb + q * NGW; const int rr = r < ML ? r : rb;
#pragma unroll
            for (int j = 0; j < 4; ++j) v[q][j] = ((const f32x4*)(h + (size_t)rr * D))[lane + 64 * j]; }
#pragma unroll
        for (int q = 0; q < 2; ++q) { const int r = rb + q * NGW; if (r >= ML) break; float ss = 0.f;
#pragma unroll
            for (int j = 0; j < 4; ++j) ss += v[q][j][0] * v[q][j][0] + v[q][j][1] * v[q][j][1] + v[q][j][2] * v[q][j][2] + v[q][j][3] * v[q][j][3];
            const float rstd = rsqrtf(wave_sum(ss) * (1.f / D) + 1e-6f);
#pragma unroll
            for (int j = 0; j < 4; ++j) ((f32x4*)(h + (size_t)r * D))[lane + 64 * j] = v[q][j] * rstd * gg[j];
        }
    }
}

__device__ __forceinline__ void prep_pool_phase(const int tid, const int bid, const int G, const bf16_t* __restrict__ Z, bf16_t* __restrict__ AQ, bf16_t* __restrict__ Kb, bf16_t* __restrict__ ymix, const float* __restrict__ gq, const float* __restrict__ gkv, int nrows, int nrows_pool) {
    const int lane = tid & 63, gw = bid * 8 + (tid >> 6), NGW = G * 8;
    for (int r = gw; r < nrows; r += NGW) {
        const bf16_t* zr = Z + (size_t)r * ZW; bf16_t* ar = AQ + (size_t)r * KQ;
        const int l32 = lane & 31;
        const bf16_t rx0 = zr[lane], rx1 = zr[64 + lane], rx2 = zr[128 + lane], ry0 = zr[192 + lane], ry1 = zr[256 + lane], rkr = zr[320 + l32];
        const bool dopool = r < nrows_pool;
        int t, Ls, seqbase; if (r < ML) { t = r & 4095; Ls = SEQ; seqbase = r & ~4095; } else { const int rc = r - ML; t = rc & 255; Ls = CTX; seqbase = ML + (rc & ~255); }
        const int gi = lane >> 4, w = 2 << gi; int lo = t - (w >> 1), hi = lo + w; lo = lo < 0 ? 0 : lo; hi = hi > Ls ? Ls : hi;
        u32x2 qq[16]; u32x2 qc = {0u, 0u};
        if (dopool) {
#pragma unroll
            for (int j = 0; j < 16; ++j) { int tp = t - 8 + j; tp = tp < lo ? lo : (tp >= hi ? hi - 1 : tp); qq[j] = *(const u32x2*)(Z + (size_t)(seqbase + tp) * ZW + 864 + 4 * lane); }
            qc = *(const u32x2*)(zr + 864 + 4 * lane);
        }
        const float g0 = gq[lane], g1 = gq[64 + lane], g2 = gq[128 + lane], k0 = gkv[lane], k1 = gkv[64 + lane];
        const float x0 = bf2f(rx0), x1 = bf2f(rx1), x2 = bf2f(rx2), y0 = bf2f(ry0), y1 = bf2f(ry1);
        const float rq = rsqrtf(wave_sum(x0 * x0 + x1 * x1 + x2 * x2) * (1.f / 192.f) + 1e-6f);
        const float rk = rsqrtf(wave_sum(y0 * y0 + y1 * y1) * (1.f / 128.f) + 1e-6f);
        ar[lane] = f2bf(x0 * rq * g0); ar[64 + lane] = f2bf(x1 * rq * g1); ar[128 + lane] = f2bf(x2 * rq * g2);
        ar[192 + lane] = f2bf(y0 * rk * k0); ar[256 + lane] = f2bf(y1 * rk * k1);
        ar[320 + lane] = 0;
        {
            const int axis = l32 >> 4, half = (l32 >> 3) & 1, ii = l32 & 7;
            const float x = bf2f(rkr), xp = __shfl_xor(x, 8); float o = x; int b, pos;
            if (r < ML) { b = r >> 12; pos = r & 4095; const float posax = (float)(axis ? (pos & 63) : (pos >> 6));
                float rev = posax * __builtin_amdgcn_exp2f(-1.6609640474436811f * (float)ii) * 0.15915494309189535f; rev -= floorf(rev);
                const float c = __builtin_amdgcn_cosf(rev), s = __builtin_amdgcn_sinf(rev); o = half ? (xp * s + x * c) : (x * c - xp * s); }
            else { const int rc = r - ML; b = rc >> 8; pos = SEQ + (rc & 255); }
            if (lane < 32) { const bf16_t ob = f2bf(o); const int dd = 64 + half * 16 + axis * 8 + ii;
#pragma unroll
                for (int hh = 0; hh < 4; ++hh) Kb[((size_t)(b * 4 + hh) * NKEY + pos) * 96 + dd] = ob; }
        }
        if (dopool) {
            float s0 = 0.f, s1 = 0.f, s2 = 0.f, s3 = 0.f;
#pragma unroll
            for (int j = 0; j < 16; ++j) { const int tp = t - 8 + j; const bool ok = tp >= lo && tp < hi;
                s0 += ok ? bf2f(qq[j].x & 0xffffu) : 0.f; s1 += ok ? bf2f(qq[j].x >> 16) : 0.f; s2 += ok ? bf2f(qq[j].y & 0xffffu) : 0.f; s3 += ok ? bf2f(qq[j].y >> 16) : 0.f; }
            const float inv = 1.f / (float)(hi - lo);
            u32x2 o; o.x = pk2(s0 * inv - bf2f(qc.x & 0xffffu), s1 * inv - bf2f(qc.x >> 16)); o.y = pk2(s2 * inv - bf2f(qc.y & 0xffffu), s3 * inv - bf2f(qc.y >> 16));
            *(u32x2*)(ymix + (size_t)r * D + 768 + 4 * lane) = o;
        }
    }
}

__device__ __forceinline__ void sgu_phase(const int tid, const int bid, const int G, LAS unsigned char* lds, const bf16_t* Z, const float* gsgu, const bf16_t* wsb, const float* bsgu, bf16_t* ymix, int nchunks) {
    const int wid = tid >> 6, lane = tid & 63, n16 = lane & 15, q8 = lane >> 4;
    constexpr int VST = 272;
    for (int ch = bid; ch < nchunks; ch += G) {
        const int row0 = ch * 128;
        __syncthreads();
        { const int token = tid & 127, head = tid >> 7; const bf16_t* zr = Z + (size_t)(row0 + token) * ZW + 608 + head * 64;
            float v[64]; float ss = 0.f;
#pragma unroll
            for (int i = 0; i < 8; ++i) { const u32x4 q = *(const u32x4*)(zr + 8 * i); const unsigned w4[4] = {q.x, q.y, q.z, q.w};
#pragma unroll
                for (int e = 0; e < 4; ++e) { const float a = gelu_f(bf2f(w4[e] & 0xffffu)), b = gelu_f(bf2f(w4[e] >> 16)); v[8 * i + 2 * e] = a; v[8 * i + 2 * e + 1] = b; ss += a * a + b * b; } }
            const float rstd = rsqrtf(ss * (1.f / 64.f) + 1e-6f);
            f32x4 gs4[16];
#pragma unroll
            for (int c4 = 0; c4 < 16; ++c4) gs4[c4] = *(const f32x4*)(gsgu + head * 64 + 4 * c4);
#pragma unroll
            for (int c = 0; c < 64; ++c) *(LAS bf16_t*)(lds + (head * 64 + c) * VST + token * 2) = f2bf(v[c] * rstd * gs4[c >> 2][c & 3]);
        }
        __syncthreads();
        const int head = wid >> 1, phalf = wid & 1;
        bf16x8 Af[4][4];
#pragma unroll
        for (int ks = 0; ks < 4; ++ks)
#pragma unroll
            for (int pg = 0; pg < 4; ++pg) Af[ks][pg] = *(const bf16x8*)(wsb + (size_t)(head * 128 + phalf * 64 + pg * 16 + n16) * 128 + ks * 32 + q8 * 8);
        f32x4 acc[4][4];
#pragma unroll
        for (int a = 0; a < 4; ++a)
#pragma unroll
            for (int b = 0; b < 4; ++b) acc[a][b] = (f32x4){0.f, 0.f, 0.f, 0.f};
#pragma unroll
        for (int ks = 0; ks < 4; ++ks) {
            bf16x8 Bf[4];
#pragma unroll
            for (int cg2 = 0; cg2 < 4; ++cg2) Bf[cg2] = *(const LAS bf16x8*)(lds + (head * 64 + cg2 * 16 + n16) * VST + (ks * 32 + q8 * 8) * 2);
#pragma unroll
            for (int pg = 0; pg < 4; ++pg)
#pragma unroll
                for (int cg2 = 0; cg2 < 4; ++cg2) acc[pg][cg2] = __builtin_amdgcn_mfma_f32_16x16x32_bf16(Bf[cg2], Af[ks][pg], acc[pg][cg2], 0, 0, 0);
        }
        u32x2 uq[4][4]; float bias[4];
#pragma unroll
        for (int pg = 0; pg < 4; ++pg) { const int pp = phalf * 64 + pg * 16 + n16; bias[pg] = bsgu[head * 128 + pp];
#pragma unroll
            for (int cg2 = 0; cg2 < 4; ++cg2) uq[pg][cg2] = *(const u32x2*)(Z + (size_t)(row0 + pp) * ZW + 352 + head * 64 + cg2 * 16 + q8 * 4); }
#pragma unroll
        for (int pg = 0; pg < 4; ++pg) { const int pp = phalf * 64 + pg * 16 + n16, row = row0 + pp;
#pragma unroll
            for (int cg2 = 0; cg2 < 4; ++cg2) { const int c = head * 64 + cg2 * 16 + q8 * 4; const u32x2 q = uq[pg][cg2];
                const f32x4 a = acc[pg][cg2];
                u32x2 o; o.x = pk2(gelu_f(bf2f(q.x & 0xffffu)) * (a[0] + bias[pg]), gelu_f(bf2f(q.x >> 16)) * (a[1] + bias[pg])); o.y = pk2(gelu_f(bf2f(q.y & 0xffffu)) * (a[2] + bias[pg]), gelu_f(bf2f(q.y >> 16)) * (a[3] + bias[pg]));
                *(u32x2*)(ymix + (size_t)row * D + 512 + c) = o; } }
    }
    __syncthreads();
}

__device__ __forceinline__ void attn_phase(const int tid, const int bid, const int G, LAS unsigned char* lds, const bf16_t* Q, const bf16_t* Kb, const bf16_t* Vt, bf16_t* ymix, int with_ctx) {
    const int wid = tid >> 6, lane = tid & 63, n16 = lane & 15, q8 = lane >> 4;
    constexpr int KST = 208, VST = 144, KBUF = 64 * KST, VBUF = 64 * VST, BUF = KBUF + VBUF;
    const int vb = (G % 8 == 0) ? ((bid % 8) * (G / 8) + bid / 8) : bid;
    const int nunits = 512 + (with_ctx ? 32 : 0);
    for (int u = vb; u < nunits; u += G) {
        int b, h, q0, key0, nkeys, rowbase;
        if (u < 512) { b = u >> 6; h = (u >> 4) & 3; q0 = (u & 15) * 256; key0 = 0; nkeys = NKEY; rowbase = b * SEQ + q0; }
        else { const int uu = u - 512; b = uu >> 2; h = uu & 3; q0 = SEQ; key0 = SEQ; nkeys = CTX; rowbase = ML + b * CTX; }
        const int bh = b * 4 + h;
        const bf16_t* Qb = Q + ((size_t)bh * NKEY + q0 + wid * 32) * 96;
        bf16x8 Qf[2][3];
#pragma unroll
        for (int qg = 0; qg < 2; ++qg)
#pragma unroll
            for (int dc = 0; dc < 3; ++dc) Qf[qg][dc] = *(const bf16x8*)(Qb + (size_t)(qg * 16 + n16) * 96 + dc * 32 + q8 * 8);
        if (u < 512) {
#pragma unroll
            for (int qg = 0; qg < 2; ++qg) {
                const int pos = q0 + wid * 32 + qg * 16 + n16; const float posax = (float)((q8 & 1) ? (pos & 63) : (pos >> 6));
                const u32x4 me = __builtin_bit_cast(u32x4, Qf[qg][2]); u32x4 pa; pa.x = __shfl_xor(me.x, 32); pa.y = __shfl_xor(me.y, 32); pa.z = __shfl_xor(me.z, 32); pa.w = __shfl_xor(me.w, 32);
                const unsigned mw[4] = {me.x, me.y, me.z, me.w}, pw[4] = {pa.x, pa.y, pa.z, pa.w}; unsigned ow[4];
#pragma unroll
                for (int e = 0; e < 4; ++e) { float res[2];
#pragma unroll
                    for (int hf = 0; hf < 2; ++hf) { const int ii = 2 * e + hf; const float xm = bf2f(hf ? (mw[e] >> 16) : (mw[e] & 0xffffu)), xo = bf2f(hf ? (pw[e] >> 16) : (pw[e] & 0xffffu));
                        float rev = posax * __builtin_amdgcn_exp2f(-1.6609640474436811f * (float)ii) * 0.15915494309189535f; rev -= floorf(rev);
                        const float c = __builtin_amdgcn_cosf(rev), s = __builtin_amdgcn_sinf(rev);
                        res[hf] = (q8 < 2) ? (xm * c - xo * s) : (xo * s + xm * c); }
                    ow[e] = pk2(res[0], res[1]); }
                u32x4 ov; ov.x = ow[0]; ov.y = ow[1]; ov.z = ow[2]; ov.w = ow[3]; Qf[qg][2] = __builtin_bit_cast(bf16x8, ov);
            }
        }
        const bf16_t* Kg = Kb + ((size_t)bh * NKEY + key0) * 96; const bf16_t* Vg = Vt + (size_t)bh * 64 * NKEY + key0;
        const int ntiles = nkeys >> 6;
        const int kc0 = tid, kc1 = 512 + (tid & 255);
        const int klds0 = (kc0 / 12) * KST + (kc0 % 12) * 16, klds1 = (kc1 / 12) * KST + (kc1 % 12) * 16;
        const int vd = tid >> 3, vp = tid & 7, vlds = KBUF + vd * VST + vp * 16;
        u32x4 kr0, kr1, vr;
        kr0 = *(const u32x4*)(Kg + (size_t)kc0 * 8); kr1 = *(const u32x4*)(Kg + (size_t)kc1 * 8); vr = *(const u32x4*)(Vg + (size_t)vd * NKEY + vp * 8);
        __syncthreads();
        *(LAS u32x4*)(lds + klds0) = kr0; if (tid < 256) *(LAS u32x4*)(lds + klds1) = kr1; *(LAS u32x4*)(lds + vlds) = vr;
        __syncthreads();
        f32x4 O[5][2]; float mrun[2];
        const u32x4 onesw = {0x3F803F80u, 0x3F803F80u, 0x3F803F80u, 0x3F803F80u}; const bf16x8 ones = __builtin_bit_cast(bf16x8, onesw);
#pragma unroll
        for (int dg = 0; dg < 5; ++dg) { O[dg][0] = (f32x4){0.f, 0.f, 0.f, 0.f}; O[dg][1] = (f32x4){0.f, 0.f, 0.f, 0.f}; }
        mrun[0] = mrun[1] = -1e30f;
        for (int t = 0; t < ntiles; ++t) {
            const bool more = (t + 1 < ntiles);
            if (more) { const bf16_t* kn = Kg + (size_t)(t + 1) * 64 * 96; kr0 = *(const u32x4*)(kn + (size_t)kc0 * 8); kr1 = *(const u32x4*)(kn + (size_t)kc1 * 8); vr = *(const u32x4*)(Vg + (size_t)vd * NKEY + (t + 1) * 64 + vp * 8); }
            LAS unsigned char* kbuf = lds + (t & 1) * BUF; LAS unsigned char* vbuf = kbuf + KBUF;
            f32x4 S[4][2];
#pragma unroll
            for (int kg = 0; kg < 4; ++kg) {
                bf16x8 Kf[3];
#pragma unroll
                for (int dc = 0; dc < 3; ++dc) Kf[dc] = *(const LAS bf16x8*)(kbuf + (kg * 16 + n16) * KST + dc * 64 + q8 * 16);
#pragma unroll
                for (int qg = 0; qg < 2; ++qg) { f32x4 s = (f32x4){0.f, 0.f, 0.f, 0.f};
#pragma unroll
                    for (int dc = 0; dc < 3; ++dc) s = __builtin_amdgcn_mfma_f32_16x16x32_bf16(Kf[dc], Qf[qg][dc], s, 0, 0, 0);
                    S[kg][qg] = s; }
            }
            bf16x8 Pf[2][2];
#pragma unroll
            for (int qg = 0; qg < 2; ++qg) {
                if ((t & 7) == 0) {
                    float mx = fmaxf(fmaxf(S[0][qg][0], S[0][qg][1]), fmaxf(S[0][qg][2], S[0][qg][3]));
#pragma unroll
                    for (int kg = 1; kg < 4; ++kg) mx = fmaxf(mx, fmaxf(fmaxf(S[kg][qg][0], S[kg][qg][1]), fmaxf(S[kg][qg][2], S[kg][qg][3])));
                    mx = fmaxf(mx, __shfl_xor(mx, 16)); mx = fmaxf(mx, __shfl_xor(mx, 32));
                    const float mn = fmaxf(mrun[qg], mx), al = __builtin_amdgcn_exp2f(mrun[qg] - mn); mrun[qg] = mn;
#pragma unroll
                    for (int dg = 0; dg < 5; ++dg) O[dg][qg] = O[dg][qg] * al;
                }
                { const f32x2 m2 = {mrun[qg], mrun[qg]};
#pragma unroll
                    for (int kg = 0; kg < 4; ++kg) { f32x2 lo = {S[kg][qg][0], S[kg][qg][1]}, hi = {S[kg][qg][2], S[kg][qg][3]}; lo = lo - m2; hi = hi - m2;
                        S[kg][qg][0] = __builtin_amdgcn_exp2f(lo[0]); S[kg][qg][1] = __builtin_amdgcn_exp2f(lo[1]); S[kg][qg][2] = __builtin_amdgcn_exp2f(hi[0]); S[kg][qg][3] = __builtin_amdgcn_exp2f(hi[1]); } }
#pragma unroll
                for (int kt = 0; kt < 2; ++kt) { u32x4 pw; pw.x = pk2(S[2 * kt][qg][0], S[2 * kt][qg][1]); pw.y = pk2(S[2 * kt][qg][2], S[2 * kt][qg][3]);
                    pw.z = pk2(S[2 * kt + 1][qg][0], S[2 * kt + 1][qg][1]); pw.w = pk2(S[2 * kt + 1][qg][2], S[2 * kt + 1][qg][3]); Pf[qg][kt] = __builtin_bit_cast(bf16x8, pw); }
            }
#pragma unroll
            for (int dg = 0; dg < 4; ++dg)
#pragma unroll
                for (int kt = 0; kt < 2; ++kt) {
                    const u32x2 lo = *(const LAS u32x2*)(vbuf + (dg * 16 + n16) * VST + (kt * 32 + q8 * 4) * 2), hi = *(const LAS u32x2*)(vbuf + (dg * 16 + n16) * VST + (kt * 32 + 16 + q8 * 4) * 2);
                    u32x4 vw; vw.x = lo.x; vw.y = lo.y; vw.z = hi.x; vw.w = hi.y; const bf16x8 Vf = __builtin_bit_cast(bf16x8, vw);
#pragma unroll
                    for (int qg = 0; qg < 2; ++qg) O[dg][qg] = __builtin_amdgcn_mfma_f32_16x16x32_bf16(Vf, Pf[qg][kt], O[dg][qg], 0, 0, 0);
                }
#pragma unroll
            for (int kt = 0; kt < 2; ++kt)
#pragma unroll
                for (int qg = 0; qg < 2; ++qg) O[4][qg] = __builtin_amdgcn_mfma_f32_16x16x32_bf16(ones, Pf[qg][kt], O[4][qg], 0, 0, 0);
            if (more) { LAS unsigned char* nb = lds + ((t + 1) & 1) * BUF; *(LAS u32x4*)(nb + klds0) = kr0; if (tid < 256) *(LAS u32x4*)(nb + klds1) = kr1; *(LAS u32x4*)(nb + vlds) = vr; }
            __syncthreads();
        }
#pragma unroll
        for (int qg = 0; qg < 2; ++qg) { const float inv = 1.f / O[4][qg][0];
            bf16_t* op = ymix + (size_t)(rowbase + wid * 32 + qg * 16 + n16) * D + 256 + h * 64 + q8 * 4;
#pragma unroll
            for (int dg = 0; dg < 4; ++dg) { const f32x4 v = O[dg][qg] * inv; u32x2 o; o.x = pk2(v[0], v[1]); o.y = pk2(v[2], v[3]); *(u32x2*)(op + dg * 16) = o; } }
    }
}

#ifndef PHSEL
#define PHSEL 0xFFFFF
#endif
#define PHON(k) ((PHSEL >> (k)) & 1)
__device__ __forceinline__ void run_phase(const int tid, const int bid, const int G, CP* pp, int ph, LAS unsigned char* lds) {
    unsigned char* ws = pp->ws;
    float* HC = (float*)(ws + O_HC); bf16_t* A1 = (bf16_t*)(ws + O_A1); bf16_t* HID = (bf16_t*)(ws + O_U);
    bf16_t* Z = (bf16_t*)(ws + O_Z); bf16_t* ZT = (bf16_t*)(ws + O_ZT); bf16_t* ZTC = (bf16_t*)(ws + O_ZTC); bf16_t* AQ = (bf16_t*)(ws + O_AQ);
    bf16_t* Qb = (bf16_t*)(ws + O_Q); bf16_t* Kb = (bf16_t*)(ws + O_K); bf16_t* VT = (bf16_t*)(ws + O_VT);
    const float* mod = (const float*)(ws + O_MOD); float* PART = (float*)(ws + O_PART);
    if ((PHSEL & 1) && ph == 0) { phase0(tid, bid, G, pp, lds); return; }
    if (ph == NPH - 1) { final_norm(tid, bid, G, pp->out, pp->in[I_GFIN]); return; }
    const int layer = (ph - 1) / 12, loc = (ph - 1) % 12; const bool last = layer == 1;
    const unsigned char* wl = ws + O_W + (size_t)layer * W_LAYER; const float* modl = mod + (size_t)layer * 9 * NMOD;
    const int Mfull = MT, Mlate = last ? ML : MT;
    Sched S;
    switch (loc) {
    case 0: if (PHON(1)) norm_phase(tid, bid, G, layer == 0 ? pp->in[I_X] : pp->out, layer == 0 ? pp->in[I_CTX] : HC, Mfull, pp->in[I_GF1] + layer * D, modl, 0, 1, A1, layer == 0 ? nullptr : PART, HC); break;
    case 1: case 10: if (PHON(2)) { const int M = loc == 1 ? Mfull : Mlate; Gemm g{A1, (const bf16_t*)(wl + (loc == 1 ? W_13A : W_13B)), M, 2 * DFF, D}; S.init(M, 2 * DFF, G, bid); S.ntf = D / BK; EpiSwiglu E{HID}; gemm_phase(tid, lds, g, S, E); } break;
    case 2: case 11: case 8: if (PHON(3)) {
        const bool with_ctx = (loc == 2) || !last; const bool first = (loc == 2 && layer == 0);
        Gemm g; EpiResid E; E.hin_lat = first ? pp->in[I_X] : pp->out; E.hout_lat = pp->out; E.part = PART; Sched2 S2;
        if (loc == 8) { g = Gemm{A1, (const bf16_t*)(wl + W_OUT), MT, D, D}; E.gate = modl + 5 * D; E.scale = 1.f; S2.init(D, D, G, bid, with_ctx); }
        else { g = Gemm{HID, (const bf16_t*)(wl + (loc == 2 ? W_2A : W_2B)), MT, D, DFF}; E.gate = modl + (loc == 2 ? 2 : 8) * D; E.scale = 0.5f; S2.init(D, DFF, G, bid, with_ctx); }
        gemm_phase(tid, lds, g, S2, E);
        if (loc == 2 && layer == 0 && bid >= G / 2) { __syncthreads(); weight_transposes(pp, lds, 1, (bid - G / 2) * 8 + (tid >> 6), (G - G / 2) * 8, tid >> 6, tid & 63); } } break;
    case 3: if (PHON(1)) norm_phase(tid, bid, G, pp->out, HC, Mfull, pp->in[I_GMIX] + layer * D, modl, 3, 4, A1, PART, HC); break;
    case 4: if (PHON(4)) { Gemm g{A1, (const bf16_t*)(wl + W_IN), Mfull, NIN, D}; S.init(Mfull, NIN, G, bid); S.ntf = D / BK; EpiInproj E{Z, ZT, ZTC}; gemm_phase(tid, lds, g, S, E); } break;
    case 5: if (PHON(5)) {
        if (PHON(8)) prep_pool_phase(tid, bid, G, Z, AQ, Kb, A1, pp->in[I_GQ] + layer * 192, pp->in[I_GKV] + layer * 128, Mfull, Mlate);
        if (PHON(9)) sgu_phase(tid, bid, G, lds, Z, pp->in[I_GSGU] + layer * 256, (const bf16_t*)(wl + W_S), pp->in[I_BSGU] + layer * 512, A1, Mlate / 128);
        if (PHON(10)) fourier_pre(tid, bid, G, ZT, (bf16_t*)(ws + O_FE), (bf16_t*)(ws + O_FO), (float*)(ws + O_FX));
    } break;
    case 6: if (PHON(6)) {
        if (bid < 128) {
            const int sn = bid >> 6; int c2 = bid & 63; asm volatile("" : "+s"(c2));
            Gemm g{(const bf16_t*)(ws + O_DFT) + (size_t)sn * 2048 * 2048, (const bf16_t*)(ws + (sn ? O_FO : O_FE)), 2048, NB * 256, 2048}; S.init(2048, NB * 256, 64, c2); S.ntf = 2048 / BK;
            EpiF32 E{(float*)(ws + (sn ? O_SO : O_CE)), 2048}; gemm_phase(tid, lds, g, S, E);
        } else {
            int K2 = KQ, c2 = bid - 128; asm volatile("" : "+s"(K2), "+s"(c2));
            Gemm g{AQ, (const bf16_t*)(wl + W_QKV), Mfull, 1024, K2}; S.init(Mfull, 1024, G - 128, c2); S.ntf = K2 / BK; EpiQkv E{Qb, Kb, VT, 0.14724445f}; gemm_phase(tid, lds, g, S, E);
            if (!last) { __syncthreads(); int K3 = 512, c3 = bid - (G - 8); asm volatile("" : "+s"(K3), "+s"(c3)); Gemm g2{(const bf16_t*)(ws + O_DFTC), ZTC, CTX, NB * 256, K3}; S.init(CTX, NB * 256, 8, c3); S.ntf = K3 / BK; EpiFourier E2{A1, ML, CTX}; gemm_phase(tid, lds, g2, S, E2); }
        }
    } break;
    case 7: if (PHON(7)) { fourier_post(tid, bid, G, (const float*)(ws + O_CE), (const float*)(ws + O_SO), (const float*)(ws + O_FX), A1); attn_phase(tid, bid, G, lds, Qb, Kb, VT, A1, last ? 0 : 1); } break;
    case 9: if (PHON(1)) norm_phase(tid, bid, G, pp->out, HC, Mlate, pp->in[I_GF2] + layer * D, modl, 6, 7, A1, PART, HC); break;
    default: break;
    }
}

__global__ __launch_bounds__(512, 2) void mk_fwd(P p, int ph_lo, int ph_hi) {
    extern __shared__ __attribute__((aligned(16))) unsigned char shm[];
    LAS unsigned char* lds = (LAS unsigned char*)shm;
    cg::grid_group grid = cg::this_grid();
    const int wv = __builtin_amdgcn_readfirstlane((int)(threadIdx.x >> 6));
    volatile LAS unsigned* st = (volatile LAS unsigned*)(lds + LDS_BYTES - 16);
    unsigned xcc = 0; unsigned* bar = nullptr;
    if (ph_hi - ph_lo > 1) {
        CP* pp0 = (CP*)__builtin_amdgcn_kernarg_segment_ptr(); bar = (unsigned*)(pp0->ws + O_BAR); xcc = xb_xcc_id();
        if (threadIdx.x == 0) { st[0] = 0u; st[1] = 0u; (void)xb_add(&bar[XB_XCNT(xcc)], 1u); }
        __syncthreads();
    }
    for (int ph = ph_lo, rep = 0; ph < ph_hi;) {
        if (ph > ph_lo && rep == 0) { if (ph_hi < 0) grid.sync();
            else { int t0 = wv * 64 + (int)__builtin_amdgcn_mbcnt_hi(~0u, __builtin_amdgcn_mbcnt_lo(~0u, 0u)); xcd_barrier(bar, xcc, st, t0, gridDim.x); } }
        int wv2 = wv; asm volatile("" : "+s"(wv2));
        int tid = wv2 * 64 + (int)__builtin_amdgcn_mbcnt_hi(~0u, __builtin_amdgcn_mbcnt_lo(~0u, 0u)); asm volatile("" : "+v"(tid));
        int bid = blockIdx.x, G = gridDim.x; asm volatile("" : "+s"(bid), "+s"(G));
        CP* pp = (CP*)__builtin_amdgcn_kernarg_segment_ptr(); asm volatile("" : "+s"(pp));
        run_phase(tid, bid, G, pp, ph, lds);
        __syncthreads();
#if REPMASK
        { const int pt = ph == 0 ? 0 : (ph == NPH - 1 ? 13 : 1 + (ph - 1) % 12); const int nrep = ((REPMASK >> pt) & 1) ? REPN : 0;
          if (rep < nrep) ++rep; else { rep = 0; ++ph; } }
#else
        ++ph;
#endif
    }
}

extern "C" void kernel_launch(void* const* d_in, const int* in_sizes, int n_in, void* d_out, int out_size, void* d_ws, size_t ws_size, hipStream_t stream) {
    static int grid = 0;
    if (grid == 0) {
        if (n_in != 26 || out_size != ML * D || ws_size < WS_END) { fprintf(stderr, "kernel_launch: unexpected shapes (n_in %d out %d ws %zu need %zu)\n", n_in, out_size, ws_size, (size_t)WS_END); grid = -1; return; }
        int dev = 0, cus = 0, per_cu = 0;
        hipGetDevice(&dev); hipDeviceGetAttribute(&cus, hipDeviceAttributeMultiprocessorCount, dev);
        if (hipFuncSetAttribute((const void*)mk_fwd, hipFuncAttributeMaxDynamicSharedMemorySize, LDS_BYTES) != hipSuccess) { fprintf(stderr, "kernel_launch: hipFuncSetAttribute failed\n"); grid = -1; return; }
        if (hipOccupancyMaxActiveBlocksPerMultiprocessor(&per_cu, (const void*)mk_fwd, 512, LDS_BYTES) != hipSuccess || per_cu < 1) { fprintf(stderr, "kernel_launch: occupancy query says %d\n", per_cu); per_cu = 1; }
        (void)hipGetLastError();
        grid = cus * 1;
    }
    if (grid < 0) return;
    if (ONE_LAUNCH) (void)hipMemsetAsync((unsigned char*)d_ws + O_BAR, 0, 16384, stream);
    P p{};
    for (int i = 0; i < 26; ++i) p.in[i] = (const float*)d_in[i];
    p.out = (float*)d_out; p.ws = (unsigned char*)d_ws;
#if ONE_LAUNCH
    int lo = 0, hi = NPH; void* args[] = {&p, &lo, &hi};
    hipError_t e = hipLaunchCooperativeKernel((const void*)mk_fwd, dim3(grid), dim3(512), args, LDS_BYTES, stream);
    if (e != hipSuccess) fprintf(stderr, "cooperative launch failed: %s (grid %d)\n", hipGetErrorString(e), grid);
#else
    for (int ph = 0; ph < NPH; ++ph) hipLaunchKernelGGL(mk_fwd, dim3(grid), dim3(512), LDS_BYTES, stream, p, ph, ph + 1);
#endif
}
```
